# Optimizing an MI355X kernel written in HIP

```python
import math
import jax, jax.numpy as jnp
from jax import lax
import numpy as np

D_MODEL = 1024
BATCH = 2
SEQ = 8192
DEPTH = 1
DEC_BATCH = 128
DEC_SEQ = 4
PAST_LEN = 16384
PAGE_SIZE = 128

N_HEADS = 8
N_KV_HEADS = 2
HEAD_DIM = 64
GQA_GROUP = N_HEADS // N_KV_HEADS
ATTN_WIDTH = N_HEADS * HEAD_DIM
KV_WIDTH = N_KV_HEADS * HEAD_DIM
WINDOW = 128
CHUNK = 128
N_GATE_GROUPS = 4
GMLP_WIDTH = D_MODEL - ATTN_WIDTH
GROUP_CH = GMLP_WIDTH // N_GATE_GROUPS
PROJ_WIDTH = ATTN_WIDTH + 2 * KV_WIDTH + 2 * GMLP_WIDTH
D_FF = 2816
RMS_EPS = 1e-6
FFN_RESIDUAL = 0.5

kernel_name = "hymba_gmlp_swa_sink_macaron_step"


def _rmsnorm(x, g):
    xf = x.astype(jnp.float32)
    y = xf * lax.rsqrt(jnp.mean(xf * xf, axis=-1, keepdims=True) + RMS_EPS)
    return (y * g.astype(jnp.float32)).astype(x.dtype)


def _ffn_half(x, norm, wg, wu, wd):
    h = _rmsnorm(x, norm)
    return x + FFN_RESIDUAL * ((jax.nn.silu(h @ wg) * (h @ wu)) @ wd)


def _alibi_slopes():
    s = 2.0 ** (-8.0 * np.arange(1, N_HEADS + 1, dtype=np.float32) / N_HEADS)
    return jnp.asarray(s.astype(np.float32)).reshape(N_KV_HEADS, GQA_GROUP)


def _project(h, w_in):
    p = h @ w_in
    c1 = ATTN_WIDTH
    c2 = c1 + KV_WIDTH
    c3 = c2 + KV_WIDTH
    c4 = c3 + GMLP_WIDTH
    q, k, v, u, g = jnp.split(p, [c1, c2, c3, c4], axis=-1)
    lead = h.shape[:-1]
    q = q.reshape(*lead, N_KV_HEADS, GQA_GROUP, HEAD_DIM)
    k = k.reshape(*lead, N_KV_HEADS, HEAD_DIM)
    v = v.reshape(*lead, N_KV_HEADS, HEAD_DIM)
    u = jax.nn.gelu(u).reshape(*lead, N_GATE_GROUPS, GROUP_CH)
    g = jax.nn.gelu(g).reshape(*lead, N_GATE_GROUPS, GROUP_CH)
    return q, k, v, u, g


def _sink_attention(q, k, v, dist, valid, sinks):
    slopes = _alibi_slopes()
    s = jnp.einsum('...qhgd,...khd->...hgqk', q, k).astype(jnp.float32) / math.sqrt(HEAD_DIM)
    s = s - slopes[:, :, None, None] * dist.astype(jnp.float32)
    s = jnp.where(valid, s, -jnp.inf)
    sink = jnp.broadcast_to(sinks.astype(jnp.float32).reshape(N_KV_HEADS, GQA_GROUP, 1, 1),
                            s.shape[:-1] + (1,))
    p = jax.nn.softmax(jnp.concatenate([s, sink], axis=-1), axis=-1)[..., :-1]
    o = jnp.einsum('...hgqk,...khd->...qhgd', p.astype(v.dtype), v)
    return o.reshape(*o.shape[:-3], ATTN_WIDTH)


def _spatial_gate(u, g, v_norm, w_s, b_s, n):
    g = _rmsnorm(g, v_norm)
    w = jnp.tril(w_s[:, :n, :n])
    mixed = jnp.einsum('gij,...jgc->...igc', w, g) + b_s[:, :n].T[..., None]
    out = u * mixed
    return out.reshape(*u.shape[:-2], GMLP_WIDTH), g


def _merge(attn, gate, attn_out_norm, gmlp_out_norm, w_out):
    return jnp.concatenate([_rmsnorm(attn, attn_out_norm), _rmsnorm(gate, gmlp_out_norm)], axis=-1) @ w_out


def _mixer_prompt(h, w_in, sinks, v_norm, w_s, b_s, attn_out_norm, gmlp_out_norm, w_out):
    B, T, _ = h.shape
    nb = T // WINDOW
    q, k, v, u, g = _project(h, w_in)
    qb = q.reshape(B, nb, WINDOW, N_KV_HEADS, GQA_GROUP, HEAD_DIM)
    kb = k.reshape(B, nb, WINDOW, N_KV_HEADS, HEAD_DIM)
    vb = v.reshape(B, nb, WINDOW, N_KV_HEADS, HEAD_DIM)
    pad = ((0, 0), (1, 0), (0, 0), (0, 0), (0, 0))
    k_band = jnp.concatenate([jnp.pad(kb, pad)[:, :-1], kb], axis=2)
    v_band = jnp.concatenate([jnp.pad(vb, pad)[:, :-1], vb], axis=2)
    i = jnp.arange(WINDOW)[:, None]
    j = jnp.arange(2 * WINDOW)[None, :]
    dist = WINDOW + i - j
    valid = (dist >= 0) & (dist < WINDOW)
    has_prev = (jnp.arange(nb)[:, None, None] > 0) | (j >= WINDOW)[None]
    valid_full = (valid[None] & has_prev)[:, None, None]
    attn = _sink_attention(qb, k_band, v_band, dist, valid_full, sinks).reshape(B, T, ATTN_WIDTH)
    uc = u.reshape(B, T // CHUNK, CHUNK, N_GATE_GROUPS, GROUP_CH)
    gc = g.reshape(B, T // CHUNK, CHUNK, N_GATE_GROUPS, GROUP_CH)
    gate, _ = _spatial_gate(uc, gc, v_norm, w_s, b_s, CHUNK)
    gate = gate.reshape(B, T, GMLP_WIDTH)
    out = _merge(attn, gate, attn_out_norm, gmlp_out_norm, w_out)
    return out, k[:, T - WINDOW:], v[:, T - WINDOW:]


def _mixer_sample(h, cache_k, cache_v, w_in, sinks, v_norm, w_s, b_s, attn_out_norm, gmlp_out_norm, w_out):
    n = h.shape[1]
    L = cache_k.shape[1]
    q, k, v, u, g = _project(h, w_in)
    k_all = jnp.concatenate([cache_k.astype(k.dtype), k], axis=1)
    v_all = jnp.concatenate([cache_v.astype(v.dtype), v], axis=1)
    i = jnp.arange(n)[:, None]
    j = jnp.arange(L + n)[None, :]
    dist = L + i - j
    valid = (dist >= 0) & (dist < WINDOW)
    attn = _sink_attention(q, k_all, v_all, dist, valid, sinks)
    gate, g_n = _spatial_gate(u, g, v_norm, w_s, b_s, n)
    out = _merge(attn, gate, attn_out_norm, gmlp_out_norm, w_out)
    return out, k_all[:, -L:], v_all[:, -L:], g_n.reshape(h.shape[0], n, GMLP_WIDTH)


def setup_inputs(seed: int = 0) -> dict:
    key = jax.random.key(seed)
    ks = jax.random.split(key, 24)
    cache_rows = min(WINDOW, PAST_LEN)

    def nrm(k, shape, scale):
        return jax.random.normal(k, shape, jnp.float32) * scale

    def gain(k, shape):
        return 1.0 + 0.02 * jax.random.normal(k, shape, jnp.float32)

    return {
        "x_prompt": nrm(ks[0], (BATCH, SEQ, D_MODEL), 1.0),
        "x_sample": nrm(ks[1], (DEC_BATCH, DEC_SEQ, D_MODEL), 1.0),
        "cache_k": nrm(ks[2], (DEPTH, DEC_BATCH, cache_rows, N_KV_HEADS, HEAD_DIM), 1.0),
        "cache_v": nrm(ks[3], (DEPTH, DEC_BATCH, cache_rows, N_KV_HEADS, HEAD_DIM), 1.0),
        "ffn1_norm": gain(ks[4], (DEPTH, D_MODEL)),
        "ffn1_w_gate": nrm(ks[5], (DEPTH, D_MODEL, D_FF), D_MODEL ** -0.5),
        "ffn1_w_up": nrm(ks[6], (DEPTH, D_MODEL, D_FF), D_MODEL ** -0.5),
        "ffn1_w_down": nrm(ks[7], (DEPTH, D_FF, D_MODEL), D_FF ** -0.5),
        "mix_norm": gain(ks[8], (DEPTH, D_MODEL)),
        "w_in": nrm(ks[9], (DEPTH, D_MODEL, PROJ_WIDTH), D_MODEL ** -0.5),
        "attn_sinks": nrm(ks[10], (DEPTH, N_HEADS), 1.0),
        "gmlp_v_norm": gain(ks[11], (DEPTH, N_GATE_GROUPS, GROUP_CH)),
        "gmlp_w_spatial": nrm(ks[12], (DEPTH, N_GATE_GROUPS, CHUNK, CHUNK), 0.5 * CHUNK ** -0.5),
        "gmlp_b_spatial": gain(ks[13], (DEPTH, N_GATE_GROUPS, CHUNK)),
        "attn_out_norm": gain(ks[14], (DEPTH, ATTN_WIDTH)),
        "gmlp_out_norm": gain(ks[15], (DEPTH, GMLP_WIDTH)),
        "w_out": nrm(ks[16], (DEPTH, D_MODEL, D_MODEL), D_MODEL ** -0.5),
        "ffn2_norm": gain(ks[17], (DEPTH, D_MODEL)),
        "ffn2_w_gate": nrm(ks[18], (DEPTH, D_MODEL, D_FF), D_MODEL ** -0.5),
        "ffn2_w_up": nrm(ks[19], (DEPTH, D_MODEL, D_FF), D_MODEL ** -0.5),
        "ffn2_w_down": nrm(ks[20], (DEPTH, D_FF, D_MODEL), D_FF ** -0.5),
        "final_norm": gain(ks[21], (D_MODEL,)),
    }


def reference(x_prompt, x_sample, cache_k, cache_v, ffn1_norm, ffn1_w_gate, ffn1_w_up, ffn1_w_down,
              mix_norm, w_in, attn_sinks, gmlp_v_norm, gmlp_w_spatial, gmlp_b_spatial,
              attn_out_norm, gmlp_out_norm, w_out, ffn2_norm, ffn2_w_gate, ffn2_w_up, ffn2_w_down,
              final_norm):
    xp, xs = x_prompt, x_sample
    pk, pv, sk, sv, sc = [], [], [], [], []
    for l in range(DEPTH):
        xp = _ffn_half(xp, ffn1_norm[l], ffn1_w_gate[l], ffn1_w_up[l], ffn1_w_down[l])
        xs = _ffn_half(xs, ffn1_norm[l], ffn1_w_gate[l], ffn1_w_up[l], ffn1_w_down[l])
        mp, kp, vp = _mixer_prompt(_rmsnorm(xp, mix_norm[l]), w_in[l], attn_sinks[l], gmlp_v_norm[l],
                                   gmlp_w_spatial[l], gmlp_b_spatial[l], attn_out_norm[l],
                                   gmlp_out_norm[l], w_out[l])
        ms, ks_, vs_, cs = _mixer_sample(_rmsnorm(xs, mix_norm[l]), cache_k[l], cache_v[l], w_in[l],
                                         attn_sinks[l], gmlp_v_norm[l], gmlp_w_spatial[l],
                                         gmlp_b_spatial[l], attn_out_norm[l], gmlp_out_norm[l], w_out[l])
        xp = xp + mp
        xs = xs + ms
        xp = _ffn_half(xp, ffn2_norm[l], ffn2_w_gate[l], ffn2_w_up[l], ffn2_w_down[l])
        xs = _ffn_half(xs, ffn2_norm[l], ffn2_w_gate[l], ffn2_w_up[l], ffn2_w_down[l])
        pk.append(kp); pv.append(vp); sk.append(ks_); sv.append(vs_); sc.append(cs)
    y_prompt = _rmsnorm(xp, final_norm)
    y_sample = _rmsnorm(xs, final_norm)
    prompt_k = jnp.stack(pk, axis=0)
    prompt_v = jnp.stack(pv, axis=0)
    sample_k = jnp.stack(sk, axis=0)
    sample_v = jnp.stack(sv, axis=0)
    sample_chunk_v = jnp.stack(sc, axis=0)
    return (y_prompt, y_sample, prompt_k, prompt_v, sample_k, sample_v, sample_chunk_v)
```

```cpp
#include <hip/hip_runtime.h>
#include <cstdio>
#include <cstdint>
#define MK_Y_AUX 2
__device__ __forceinline__ int hw_lane() { int l = (int)__builtin_amdgcn_mbcnt_hi(~0u, __builtin_amdgcn_mbcnt_lo(~0u, 0u)); asm volatile("" : "+v"(l)); return l; }
namespace pg8 {
#define PG8_LAS __attribute__((address_space(3)))
typedef unsigned short bf16_t;
typedef short bf16x8 __attribute__((ext_vector_type(8)));
typedef float f32x4 __attribute__((ext_vector_type(4)));
typedef unsigned u32x4 __attribute__((ext_vector_type(4)));
constexpr int BM = 256, BK = 64, HALF = 128, HTB = HALF * BK * 2  , STAGE_BYTES = 8 * HTB, NXCD = 8, WGM = 8;

__host__ __device__ __forceinline__ int lds_byte(int r, int c) { const int st = (r >> 4) * 2 + (c >> 5), rr = r & 15, cc = c & 31, ob = rr * 64 + cc * 2; return st * 1024 + (ob ^ (((ob >> 9) & 1) << 5)); }
__host__ __device__ __forceinline__ void stage_rc(int b, int& R, int& C) { const int st = b / 1024, sb = b % 1024, swz = sb ^ (((sb >> 9) & 1) << 5); R = (st >> 1) * 16 + swz / 64; C = (st & 1) * 32 + (swz % 64) / 2; }
__host__ __device__ __forceinline__ int perm32(int rho) { const int n = rho >> 4, i = rho & 15; return 8 * (i >> 2) + 4 * n + (i & 3); }

struct Unit { int pm, pn; };
struct Gemm { const bf16_t* A; const bf16_t* Bt; int M, N, K; };

struct StaticOrder {
    int nM, nN, nwg, G, c;
    __host__ __device__ void init(int M, int N, int G_, int c_) { nM = M / BM; nN = N / BM; nwg = nM * nN; G = G_; c = c_; }
    __host__ __device__ bool next(int i, Unit& u) const {
        const long L = (long)i * G + c; if (L >= nwg) return false;
        int wgid = (int)L; { const int q = nwg / NXCD, r = nwg % NXCD, xcd = wgid % NXCD, off = wgid / NXCD; wgid = (xcd < r ? xcd * (q + 1) : r * (q + 1) + (xcd - r) * q) + off; }
        const int nig = WGM * nN, gid = wgid / nig, fm = gid * WGM, gsz = (nM - fm) < WGM ? (nM - fm) : WGM;
        u.pm = fm + ((wgid % nig) % gsz); u.pn = (wgid % nig) / gsz; return true;
    }
    __device__ __forceinline__ void a_ready(const Unit&) const {}
    __device__ __forceinline__ void done(const Unit&) const {}
};
__device__ __forceinline__ unsigned cvt_pk_bf16(float lo, float hi) { unsigned r; asm volatile("v_cvt_pk_bf16_f32 %0, %1, %2" : "=v"(r) : "v"(lo), "v"(hi)); return r; }
typedef float f32x2 __attribute__((ext_vector_type(2)));

constexpr float RMS_EPS_F = 1e-6f;
__device__ __forceinline__ float fast_sigmoid(float z) { return __builtin_amdgcn_rcpf(1.0f + __builtin_amdgcn_exp2f(-1.4426950408889634f * z)); }
__device__ __forceinline__ float silu_f(float x) { return x * fast_sigmoid(x); }
__device__ __forceinline__ float gelu_tanh_f(float x) { const float z = 1.5957691216057308f * (x + 0.044715f * x * x * x); return x * fast_sigmoid(z); }
#ifndef MK_WT_STORES
#define MK_WT_STORES 1
#endif
__device__ __forceinline__ void st16(void* base  , size_t elem_off  , const u32x4& v) {
#if MK_WT_STORES
    __builtin_amdgcn_raw_buffer_store_b128(v, __builtin_amdgcn_make_buffer_rsrc(base, 0, 0x7fffffff, 0x00020000), (unsigned)(elem_off * 2), 0, 16);
#else
    *(u32x4*)((bf16_t*)base + elem_off) = v;
#endif
}
#ifndef MK_Y_FULL
#define MK_Y_FULL 1
#endif
#ifndef MK_WT_Y
#define MK_WT_Y 1
#endif
#ifndef MK_Y_AUX
#define MK_Y_AUX 16
#endif
__device__ __forceinline__ void st16f(float* base  , size_t elem_off  , const f32x4& v) {
#if MK_WT_Y
    __builtin_amdgcn_raw_buffer_store_b128(__builtin_bit_cast(u32x4, v), __builtin_amdgcn_make_buffer_rsrc(base, 0, 0x7fffffff, 0x00020000), (unsigned)(elem_off * 4), 0, MK_Y_AUX);
#else
    *(f32x4*)(base + elem_off) = v;
#endif
}
__device__ __forceinline__ u32x4 pack8(const f32x4& a, const f32x4& b) { u32x4 w; w.x = cvt_pk_bf16(a[0], a[1]); w.y = cvt_pk_bf16(a[2], a[3]); w.z = cvt_pk_bf16(b[0], b[1]); w.w = cvt_pk_bf16(b[2], b[3]); return w; }

typedef float f32x2 __attribute__((ext_vector_type(2)));
__device__ __forceinline__ f32x2 swiglu2(const f32x2 g, const f32x2 u, const f32x2 c1, const f32x2 r2) {
    const f32x2 z = g * c1; f32x2 e; e[0] = __builtin_amdgcn_exp2f(z[0]); e[1] = __builtin_amdgcn_exp2f(z[1]);
    const f32x2 d = e + 1.0f; f32x2 s; s[0] = __builtin_amdgcn_rcpf(d[0]); s[1] = __builtin_amdgcn_rcpf(d[1]);
    return ((g * u) * r2) * s; }
__device__ __forceinline__ f32x2 gelu2(const f32x2 x) {
    constexpr float kc = -1.4426950408889634f * 1.5957691216057308f;
    const f32x2 p = (x * x) * (0.044715f * kc) + kc, z = x * p; f32x2 e; e[0] = __builtin_amdgcn_exp2f(z[0]); e[1] = __builtin_amdgcn_exp2f(z[1]);
    const f32x2 d = e + 1.0f; f32x2 s; s[0] = __builtin_amdgcn_rcpf(d[0]); s[1] = __builtin_amdgcn_rcpf(d[1]);
    return x * s; }
struct EpiSwiGLU {
    static constexpr bool PERM = true, AFTER_DRAIN = false;
    bf16_t* H; int ldh; const float* ssq;
    __device__ __forceinline__ void operator()(f32x4 (&acc)[2][2][4][2], const Unit& u, int wr, int wc, int fr, int fq) const {
        asm volatile("" : "+v"(fr), "+v"(fq));
        const int row0 = u.pm * BM + wr * 64 + fr, col0 = u.pn * 128 + wc * 32 + 8 * fq;
        float rs[2][4];
#pragma unroll
        for (int ai = 0; ai < 2; ++ai)
#pragma unroll
            for (int m = 0; m < 4; ++m) rs[ai][m] = ssq[row0 + ai * HALF + m * 16];
        __builtin_amdgcn_sched_barrier(0);
#pragma unroll
        for (int ai = 0; ai < 2; ++ai)
#pragma unroll
            for (int m = 0; m < 4; ++m) { const int row = row0 + ai * HALF + m * 16;
                const float r = __builtin_amdgcn_rsqf(rs[ai][m] * (1.0f / 1024.0f) + RMS_EPS_F), c1s = -1.4426950408889634f * r, r2s = r * r;
                const f32x2 c1 = {c1s, c1s}, r2 = {r2s, r2s};
                u32x4 w;
#pragma unroll
                for (int n = 0; n < 2; ++n) { const f32x4 G = acc[ai][0][m][n], U = acc[ai][1][m][n];
                    const f32x2 o0 = swiglu2(__builtin_shufflevector(G, G, 0, 1), __builtin_shufflevector(U, U, 0, 1), c1, r2), o1 = swiglu2(__builtin_shufflevector(G, G, 2, 3), __builtin_shufflevector(U, U, 2, 3), c1, r2);
                    w[2 * n] = cvt_pk_bf16(o0[0], o0[1]); w[2 * n + 1] = cvt_pk_bf16(o1[0], o1[1]); }
                st16(H, (size_t)row * ldh + col0, w); }
    }
};

__device__ __forceinline__ void unpack8(const u32x4& w, f32x4& a, f32x4& b) {
    a[0] = __uint_as_float(w.x << 16); a[1] = __uint_as_float(w.x & 0xffff0000u); a[2] = __uint_as_float(w.y << 16); a[3] = __uint_as_float(w.y & 0xffff0000u);
    b[0] = __uint_as_float(w.z << 16); b[1] = __uint_as_float(w.z & 0xffff0000u); b[2] = __uint_as_float(w.w << 16); b[3] = __uint_as_float(w.w & 0xffff0000u); }
struct EpiRes {
    static constexpr bool PERM = true, AFTER_DRAIN = false;
    bf16_t* XB; float* ssq; float scale;
    __device__ __forceinline__ void operator()(f32x4 (&acc)[2][2][4][2], const Unit& u, int wr, int wc, int fr, int fq) const {
        asm volatile("" : "+v"(fr), "+v"(fq));
        const int row0 = u.pm * BM + wr * 64 + fr, col0 = u.pn * BM + wc * 32 + 8 * fq;
#pragma unroll
        for (int ai = 0; ai < 2; ++ai) {
        u32x4 raw[4][2];
#pragma unroll
            for (int m = 0; m < 4; ++m)
#pragma unroll
                for (int bj = 0; bj < 2; ++bj) raw[m][bj] = *(const u32x4*)(XB + (size_t)(row0 + ai * HALF + m * 16) * 1024 + col0 + bj * HALF);
        __builtin_amdgcn_sched_barrier(0);
#pragma unroll
            for (int m = 0; m < 4; ++m) { const int row = row0 + ai * HALF + m * 16; const size_t off = (size_t)row * 1024 + col0; float s = 0.f;
#pragma unroll
                for (int bj = 0; bj < 2; ++bj) { f32x4 b0, b1; unpack8(raw[m][bj], b0, b1);
                    const f32x4 o0 = b0 + acc[ai][bj][m][0] * scale, o1 = b1 + acc[ai][bj][m][1] * scale;
                    st16(XB, off + bj * HALF, pack8(o0, o1));
                    s += (o0[0] * o0[0] + o0[1] * o0[1]) + (o0[2] * o0[2] + o0[3] * o0[3]) + (o1[0] * o1[0] + o1[1] * o1[1]) + (o1[2] * o1[2] + o1[3] * o1[3]); }
                s += __shfl_xor(s, 16); s += __shfl_xor(s, 32);
                if (fq == 0) atomicAdd(ssq + row, s); }
        __builtin_amdgcn_sched_barrier(0); }
    }
};
struct EpiFinal {
    static constexpr bool PERM = true, AFTER_DRAIN = false;
    const bf16_t* XB; float* ssq; float scale; float* out; const float* gain; unsigned* cnt;
    __device__ __forceinline__ void operator()(f32x4 (&acc)[2][2][4][2], const Unit& u, int wr, int wc, int fr, int fq) const {
        asm volatile("" : "+v"(fr), "+v"(fq));
        const int row0 = u.pm * BM + wr * 64 + fr, col0 = u.pn * BM + wc * 32 + 8 * fq;
#pragma unroll
        for (int ai = 0; ai < 2; ++ai) {
        u32x4 raw[4][2];
#pragma unroll
            for (int m = 0; m < 4; ++m)
#pragma unroll
                for (int bj = 0; bj < 2; ++bj) raw[m][bj] = *(const u32x4*)(XB + (size_t)(row0 + ai * HALF + m * 16) * 1024 + col0 + bj * HALF);
        __builtin_amdgcn_sched_barrier(0);
#pragma unroll
            for (int m = 0; m < 4; ++m) { const int row = row0 + ai * HALF + m * 16; float s = 0.f;
#pragma unroll
                for (int bj = 0; bj < 2; ++bj) { f32x4 b0, b1; unpack8(raw[m][bj], b0, b1);
                    const f32x4 o0 = b0 + acc[ai][bj][m][0] * scale, o1 = b1 + acc[ai][bj][m][1] * scale; acc[ai][bj][m][0] = o0; acc[ai][bj][m][1] = o1;
                    s += (o0[0] * o0[0] + o0[1] * o0[1]) + (o0[2] * o0[2] + o0[3] * o0[3]) + (o1[0] * o1[0] + o1[1] * o1[1]) + (o1[2] * o1[2] + o1[3] * o1[3]); }
                s += __shfl_xor(s, 16); s += __shfl_xor(s, 32);
                if (fq == 0) atomicAdd(ssq + row, s); }
        __builtin_amdgcn_sched_barrier(0); }
        f32x4 g[2][2];
#pragma unroll
        for (int bj = 0; bj < 2; ++bj) { g[bj][0] = *(const f32x4*)(gain + col0 + bj * HALF); g[bj][1] = *(const f32x4*)(gain + col0 + bj * HALF + 4); }
        asm volatile("s_waitcnt vmcnt(0)" ::: "memory");
        unsigned* c = cnt + 64 * u.pm;
        if (fr == 0 && fq == 0) __hip_atomic_fetch_add(c, 1u, __ATOMIC_RELAXED, __HIP_MEMORY_SCOPE_AGENT);
        for (unsigned polls = 0; (unsigned)__builtin_amdgcn_readfirstlane(__hip_atomic_load(c, __ATOMIC_RELAXED, __HIP_MEMORY_SCOPE_AGENT)) < 32u && polls < (1u << 20); ++polls) __builtin_amdgcn_s_sleep(2);
        float tot[2][4];
#pragma unroll
        for (int ai = 0; ai < 2; ++ai)
#pragma unroll
            for (int m = 0; m < 4; ++m) tot[ai][m] = __hip_atomic_load(ssq + row0 + ai * HALF + m * 16, __ATOMIC_RELAXED, __HIP_MEMORY_SCOPE_AGENT);
        __builtin_amdgcn_sched_barrier(0);
#ifndef MK_YDUP
#define MK_YDUP 1
#endif
#pragma unroll
        for (int ydup = 0; ydup < MK_YDUP; ++ydup) {
#pragma unroll
        for (int ai = 0; ai < 2; ++ai)
#pragma unroll
            for (int m = 0; m < 4; ++m) { const int row = row0 + ai * HALF + m * 16; const size_t off = (size_t)row * 1024 + col0;
                const float r = __builtin_amdgcn_rsqf(tot[ai][m] * (1.0f / 1024.0f) + RMS_EPS_F);
#pragma unroll
                for (int bj = 0; bj < 2; ++bj) {
#if MK_Y_FULL
                    const f32x4 p0 = acc[ai][bj][m][0] * r * g[bj][0], p1 = acc[ai][bj][m][1] * r * g[bj][1]; f32x4 dA, dB;
#pragma unroll
                    for (int j = 0; j < 4; ++j) {
                        dA[j] = __int_as_float(__builtin_amdgcn_update_dpp(__float_as_int(p0[j]), __float_as_int(p1[j]), 0x128  , 0xf, 0xc  , false));
                        dB[j] = __int_as_float(__builtin_amdgcn_update_dpp(__float_as_int(p1[j]), __float_as_int(p0[j]), 0x128, 0xf, 0x3  , false)); }
                    const int hf = (fr >> 3) & 1; const size_t offA = (size_t)(row - 8 * hf) * 1024 + col0 + bj * HALF + 4 * hf;
                    st16f(out, offA, dA); st16f(out, offA + 8 * 1024, dB);
#else
                    *(f32x4*)(out + off + bj * HALF) = acc[ai][bj][m][0] * r * g[bj][0]; *(f32x4*)(out + off + bj * HALF + 4) = acc[ai][bj][m][1] * r * g[bj][1];
#endif
                } }
        if (ydup + 1 < MK_YDUP) asm volatile("" ::: "memory"); }
    }
};

struct EpiProj {
    static constexpr bool PERM = true, AFTER_DRAIN = false;
    bf16_t *Q, *K, *V, *U, *G; const float* ssq; float *pk, *pv, *sk, *sv; float* ssqg;
    __device__ __forceinline__ void operator()(f32x4 (&acc)[2][2][4][2], const Unit& u, int wr, int wc, int fr, int fq) const {
        asm volatile("" : "+v"(fr), "+v"(fq));
        const int row0 = u.pm * BM + wr * 64 + fr, cw = wc * 32 + 8 * fq; const int pn = u.pn;
        float rs[2][4];
#pragma unroll
        for (int ai = 0; ai < 2; ++ai)
#pragma unroll
            for (int m = 0; m < 4; ++m) rs[ai][m] = ssq[row0 + ai * HALF + m * 16];
        __builtin_amdgcn_sched_barrier(0);
#pragma unroll
        for (int ai = 0; ai < 2; ++ai)
#pragma unroll
            for (int m = 0; m < 4; ++m) { const int row = row0 + ai * HALF + m * 16;
                const float r = __builtin_amdgcn_rsqf(rs[ai][m] * (1.0f / 1024.0f) + RMS_EPS_F);
#pragma unroll
                for (int bj = 0; bj < 2; ++bj) { f32x4 v0 = acc[ai][bj][m][0] * r, v1 = acc[ai][bj][m][1] * r;
                    if (pn < 2) { const float qs = 0.125f * 1.4426950408889634f; v0 = v0 * qs; v1 = v1 * qs;
                        st16(Q, (size_t)row * 512 + pn * 256 + bj * HALF + cw, pack8(v0, v1)); }
                    else if (pn == 2) { bf16_t* dst = bj ? V : K; st16(dst, (size_t)row * 128 + cw, pack8(v0, v1));
                        if (u.pm >= 64) { const unsigned sr = (unsigned)(row - 16384); float* fo = (bj ? sv : sk) + (((sr >> 2) * 128u + 124u + (sr & 3u)) * 128u + (unsigned)cw); *(f32x4*)fo = v0; *(f32x4*)(fo + 4) = v1; }
                        else if ((u.pm & 31) == 31 && ai == 1) { const unsigned w = (unsigned)(wr * 64 + m * 16 + fr); float* fo = (bj ? pv : pk) + (((unsigned)(u.pm >> 5) * 128u + w) * 128u + (unsigned)cw); *(f32x4*)fo = v0; *(f32x4*)(fo + 4) = v1; } }
                    else {
#pragma unroll
                        for (int h = 0; h < 2; ++h) { f32x4& v = h ? v1 : v0; const f32x2 a = gelu2(__builtin_shufflevector(v, v, 0, 1)), b = gelu2(__builtin_shufflevector(v, v, 2, 3)); v[0] = a[0]; v[1] = a[1]; v[2] = b[0]; v[3] = b[1]; }
                        bf16_t* dst = (pn < 5) ? U : G; const int ct = (pn < 5) ? pn - 3 : pn - 5;
                        st16(dst, (size_t)row * 512 + ct * 256 + bj * HALF + cw, pack8(v0, v1));
                        if (pn >= 5) { float s = (v0[0] * v0[0] + v0[1] * v0[1]) + (v0[2] * v0[2] + v0[3] * v0[3]) + (v1[0] * v1[0] + v1[1] * v1[1]) + (v1[2] * v1[2] + v1[3] * v1[3]);
                            s += __shfl_xor(s, 16); s += __shfl_xor(s, 32); if (fq == 0) atomicAdd(ssqg + (size_t)row * 4 + 2 * ct + bj, s); } } } }
    }
};
template <class Epi, class Sched, bool ALIGN_EPI = false, bool SP2 = false>
__device__ __forceinline__ void gemm_phase(PG8_LAS unsigned char* lds, const Gemm g, const Sched& S, const Epi& E, const int wid  ) {
    const int lane = hw_lane(), tid = wid * 64 + lane, wr = wid >> 2, wc = wid & 3, fr = lane & 15, fq = lane >> 4;
    const int K = g.K, nt = K / BK;
    unsigned voffA[2], voffB[2];
#pragma unroll
    for (int i = 0; i < 2; ++i) { int R, C; stage_rc(tid * 16 + i * 8192, R, C); const int Rb = Epi::PERM ? ((R & ~31) + perm32(R & 31)) : R;
        voffA[i] = (unsigned)(R * K + C) * 2u; voffB[i] = (unsigned)(Rb * K + C) * 2u; }
    const size_t kstep = (size_t)(BK * 2);
    const size_t hstep = (size_t)HALF * K * 2;
    const size_t tstep = 2 * hstep;
    const unsigned ldsw = (unsigned)wid * 1024u;
    const int aoff = lds_byte(wr * 64 + fr, fq * 8), boff = lds_byte(wc * 32 + fr, fq * 8);
#define PG8_SA(b, h) (((b) * 2 + (h)) * HTB)
#define PG8_SB(b, h) ((4 + (b) * 2 + (h)) * HTB)
#define PG8_STAGE(bufoff, gbase, voff) do { _Pragma("unroll") for (int _i = 0; _i < 2; ++_i) \
        __builtin_amdgcn_global_load_lds((const unsigned*)((const char*)(gbase) + (voff)[_i]), (PG8_LAS unsigned*)(lds + (bufoff) + ldsw + _i * 8192), 16, 0, 0); } while (0)
#define PG8_LDA(dst, b, h) do { _Pragma("unroll") for (int m = 0; m < 4; ++m) _Pragma("unroll") for (int k = 0; k < 2; ++k) dst[m][k] = *(const PG8_LAS bf16x8*)(lds + PG8_SA(b, h) + aoff + m * 2048 + k * 1024); } while (0)
#define PG8_LDB(dst, b, h) do { _Pragma("unroll") for (int n = 0; n < 2; ++n) _Pragma("unroll") for (int k = 0; k < 2; ++k) dst[n][k] = *(const PG8_LAS bf16x8*)(lds + PG8_SB(b, h) + boff + n * 2048 + k * 1024); } while (0)
#define PG8_MMA(ai, bj, At, Bt) do { __builtin_amdgcn_s_setprio(1); _Pragma("unroll") for (int m = 0; m < 4; ++m) _Pragma("unroll") for (int n = 0; n < 2; ++n) _Pragma("unroll") for (int k = 0; k < 2; ++k) \
        acc[ai][bj][m][n] = __builtin_amdgcn_mfma_f32_16x16x32_bf16(Bt[n][k], At[m][k], acc[ai][bj][m][n], 0, 0, 0); __builtin_amdgcn_s_setprio(0); } while (0)
#define PG8_WAIT_V(n) asm volatile("s_waitcnt vmcnt(" #n ")" ::: "memory")
#define PG8_WAIT_L(n) asm volatile("s_waitcnt lgkmcnt(" #n ")" ::: "memory")
#define PG8_BAR __builtin_amdgcn_s_barrier()
#define PG8_SCHED __builtin_amdgcn_sched_barrier(0)
    Unit cur, nxt; int ui = 0;
    if (!S.next(0, cur)) return;
    f32x4 acc[2][2][4][2];
#pragma unroll
    for (int a = 0; a < 2; ++a)
#pragma unroll
        for (int b = 0; b < 2; ++b)
#pragma unroll
            for (int m = 0; m < 4; ++m)
#pragma unroll
                for (int n = 0; n < 2; ++n) acc[a][b][m][n] = (f32x4){0.f, 0.f, 0.f, 0.f};
    bf16x8 At[4][2], B0[2][2], B1[2][2];
    const char* cA = (const char*)g.A + (size_t)cur.pm * tstep; const char* cB = (const char*)g.Bt + (size_t)cur.pn * tstep;
    S.a_ready(cur);
    if constexpr (SP2) {
        PG8_STAGE(PG8_SB(0, 0), cB, voffB); PG8_STAGE(PG8_SB(0, 1), cB + hstep, voffB); PG8_STAGE(PG8_SA(0, 0), cA, voffA); PG8_STAGE(PG8_SA(0, 1), cA + hstep, voffA);
        if (wr == 1) PG8_BAR;
        PG8_WAIT_V(2); PG8_BAR;
        PG8_STAGE(PG8_SB(1, 0), cB + kstep, voffB); PG8_STAGE(PG8_SA(1, 0), cA + kstep, voffA); PG8_STAGE(PG8_SB(1, 1), cB + hstep + kstep, voffB);
        PG8_WAIT_V(6); PG8_BAR;
    } else {
        PG8_STAGE(PG8_SB(0, 0), cB, voffB); PG8_STAGE(PG8_SA(0, 0), cA, voffA); PG8_STAGE(PG8_SB(0, 1), cB + hstep, voffB); PG8_STAGE(PG8_SA(0, 1), cA + hstep, voffA);
        if (wr == 1) PG8_BAR;
        PG8_WAIT_V(4); PG8_BAR;
        PG8_STAGE(PG8_SB(1, 0), cB + kstep, voffB); PG8_STAGE(PG8_SA(1, 0), cA + kstep, voffA); PG8_STAGE(PG8_SB(1, 1), cB + hstep + kstep, voffB);
        PG8_WAIT_V(6); PG8_BAR;
    }
    for (;;) {
        const bool has_next = S.next(ui + 1, nxt);
        const char* nA = has_next ? (const char*)g.A + (size_t)nxt.pm * tstep : cA; const char* nB = has_next ? (const char*)g.Bt + (size_t)nxt.pn * tstep : cB;
        for (int t = 0; t < nt; t += 2) {
            const bool last = (t == nt - 2);
            const char* a1 = cA + (size_t)(t + 1) * kstep;
            const char* a2 = last ? nA : cA + (size_t)(t + 2) * kstep; const char* b2 = last ? nB : cB + (size_t)(t + 2) * kstep;
            const char* a3 = a2 + kstep; const char* b3 = b2 + kstep;
            if (last && has_next) S.a_ready(nxt);
            if constexpr (SP2) {
            PG8_LDB(B0, 0, 0); PG8_LDB(B1, 0, 1); PG8_SCHED; PG8_LDA(At, 0, 0); PG8_STAGE(PG8_SA(1, 1), a1 + hstep, voffA);
            PG8_WAIT_V(8); PG8_WAIT_L(0); PG8_BAR; PG8_MMA(0, 0, At, B0); PG8_MMA(0, 1, At, B1); PG8_BAR; PG8_SCHED;
            PG8_LDA(At, 0, 1); PG8_STAGE(PG8_SB(0, 0), b2, voffB); PG8_STAGE(PG8_SB(0, 1), b2 + hstep, voffB); PG8_STAGE(PG8_SA(0, 0), a2, voffA);
            PG8_WAIT_V(8); PG8_WAIT_L(0); PG8_BAR; PG8_MMA(1, 0, At, B0); PG8_MMA(1, 1, At, B1); PG8_BAR; PG8_SCHED;
            PG8_LDB(B0, 1, 0); PG8_LDB(B1, 1, 1); PG8_SCHED; PG8_LDA(At, 1, 0); PG8_STAGE(PG8_SA(0, 1), a2 + hstep, voffA);
            PG8_WAIT_V(8); PG8_WAIT_L(0); PG8_BAR; PG8_MMA(0, 0, At, B0); PG8_MMA(0, 1, At, B1); PG8_BAR; PG8_SCHED;
            PG8_LDA(At, 1, 1); PG8_STAGE(PG8_SB(1, 0), b3, voffB); PG8_STAGE(PG8_SB(1, 1), b3 + hstep, voffB); PG8_STAGE(PG8_SA(1, 0), a3, voffA);
            PG8_WAIT_V(8); PG8_WAIT_L(0); PG8_BAR; PG8_MMA(1, 0, At, B0); PG8_MMA(1, 1, At, B1); PG8_BAR; PG8_SCHED;
            } else {
            PG8_LDB(B0, 0, 0); PG8_SCHED; PG8_LDA(At, 0, 0); PG8_STAGE(PG8_SA(1, 1), a1 + hstep, voffA);
            PG8_WAIT_L(8); PG8_BAR; PG8_WAIT_L(0); PG8_MMA(0, 0, At, B0); PG8_BAR; PG8_SCHED;
            PG8_LDB(B1, 0, 1); PG8_STAGE(PG8_SB(0, 0), b2, voffB);
            PG8_BAR; PG8_WAIT_L(0); PG8_MMA(0, 1, At, B1); PG8_BAR;
            PG8_LDA(At, 0, 1); PG8_STAGE(PG8_SA(0, 0), a2, voffA);
            PG8_BAR; PG8_WAIT_L(0); PG8_MMA(1, 0, At, B0); PG8_BAR; PG8_SCHED;
            PG8_STAGE(PG8_SB(0, 1), b2 + hstep, voffB);
            PG8_WAIT_V(6); PG8_BAR; PG8_MMA(1, 1, At, B1); PG8_BAR;
            PG8_LDB(B0, 1, 0); PG8_SCHED; PG8_LDA(At, 1, 0); PG8_STAGE(PG8_SA(0, 1), a2 + hstep, voffA);
            PG8_WAIT_L(8); PG8_BAR; PG8_WAIT_L(0); PG8_MMA(0, 0, At, B0); PG8_BAR; PG8_SCHED;
            PG8_LDB(B1, 1, 1); PG8_STAGE(PG8_SB(1, 0), b3, voffB);
            PG8_BAR; PG8_WAIT_L(0); PG8_MMA(0, 1, At, B1); PG8_BAR;
            PG8_LDA(At, 1, 1); PG8_STAGE(PG8_SA(1, 0), a3, voffA);
            PG8_BAR; PG8_WAIT_L(0); PG8_MMA(1, 0, At, B0); PG8_BAR; PG8_SCHED;
            PG8_STAGE(PG8_SB(1, 1), b3 + hstep, voffB);
            PG8_WAIT_V(6); PG8_BAR; PG8_MMA(1, 1, At, B1); PG8_BAR;
            }
        }
        if constexpr (ALIGN_EPI) { if (wr == 0) PG8_BAR; }
        if constexpr (!Epi::AFTER_DRAIN) { E(acc, cur, wr, wc, fr, fq); S.done(cur); }
        if (!has_next) break;
#pragma unroll
        for (int a = 0; a < 2; ++a)
#pragma unroll
            for (int b = 0; b < 2; ++b)
#pragma unroll
                for (int m = 0; m < 4; ++m)
#pragma unroll
                    for (int n = 0; n < 2; ++n) acc[a][b][m][n] = (f32x4){0.f, 0.f, 0.f, 0.f};
        cur = nxt; cA = nA; cB = nB; ++ui;
        if constexpr (ALIGN_EPI) { if (wr == 1) PG8_BAR; }
    }
    PG8_WAIT_V(0);
    if constexpr (!ALIGN_EPI) { if (wr == 0) PG8_BAR; }
    PG8_BAR;
    if constexpr (Epi::AFTER_DRAIN) { E.fused(acc, cur, wr, wc, fr, fq, lds, wid, lane); S.done(cur); }
#undef PG8_SA
#undef PG8_SB
#undef PG8_STAGE
#undef PG8_LDA
#undef PG8_LDB
#undef PG8_MMA
#undef PG8_WAIT_V
#undef PG8_WAIT_L
#undef PG8_BAR
#undef PG8_SCHED
}
}

namespace mixp {
#define MX_LAS __attribute__((address_space(3)))
typedef unsigned short bf16;
typedef short bf16x8 __attribute__((ext_vector_type(8)));
typedef short s16x4 __attribute__((ext_vector_type(4)));
typedef float f32x16 __attribute__((ext_vector_type(16)));
typedef float f32x4 __attribute__((ext_vector_type(4)));
typedef unsigned u32x4 __attribute__((ext_vector_type(4)));
typedef unsigned u32x2 __attribute__((ext_vector_type(2)));
constexpr float LOG2E = 1.4426950408889634f, EPS = 1e-6f;
constexpr int KS_STRIDE = 136, VR_STRIDE = 144, GT_STRIDE = 136, AO_STRIDE = 520;
constexpr int GR_STRIDE = 144;
constexpr int KS_OFF = 0, VT_OFF = 192 * KS_STRIDE * 2, GT_BYTES = 128 * GR_STRIDE * 2;
constexpr int SS2_OFF = 4 * GT_BYTES, SS_OFF = SS2_OFF + 1024, VN_OFF = SS_OFF + 2048, MIX_LDS_BYTES = VN_OFF + 2048;
static_assert(VT_OFF == 52224 && VT_OFF + 192 * VR_STRIDE * 2 <= SS2_OFF && SS2_OFF == 147456, "mixer LDS map");
#define MX_MFMA(a, b, c) __builtin_amdgcn_mfma_f32_32x32x16_bf16((a), (b), (c), 0, 0, 0)
#ifndef MK_MRG_WT
#define MK_MRG_WT 1
#endif
__device__ __forceinline__ void mrg_store(bf16* base, unsigned byte_off, const u32x4& v) {
#if MK_MRG_WT
    __builtin_amdgcn_raw_buffer_store_b128(v, __builtin_amdgcn_make_buffer_rsrc((void*)base, 0, 0x7fffffff, 0x00020000), byte_off, 0, 16);
#else
    *(u32x4*)((unsigned char*)base + byte_off) = v;
#endif
}
__device__ __forceinline__ float bf2f(unsigned b) { return __uint_as_float(b << 16); }
__device__ __forceinline__ unsigned f2bf(float f) { unsigned u = __float_as_uint(f); return (u + 0x7fffu + ((u >> 16) & 1u)) >> 16; }
__device__ __forceinline__ unsigned pk2(float lo, float hi) { unsigned r; asm volatile("v_cvt_pk_bf16_f32 %0, %1, %2" : "=v"(r) : "v"(lo), "v"(hi)); return r; }
__device__ __forceinline__ float wave_sum(float v) {
#pragma unroll
    for (int o = 1; o < 64; o <<= 1) v += __shfl_xor(v, o);
    return v; }
__device__ __forceinline__ float wave_max(float v) {
#pragma unroll
    for (int o = 1; o < 64; o <<= 1) v = fmaxf(v, __shfl_xor(v, o));
    return v; }
__device__ __forceinline__ bf16x8 pack_step(const f32x16& x, int s) {
    u32x4 p;
    asm volatile("v_cvt_pk_bf16_f32 %0, %4, %5\n\tv_cvt_pk_bf16_f32 %1, %6, %7\n\tv_cvt_pk_bf16_f32 %2, %8, %9\n\tv_cvt_pk_bf16_f32 %3, %10, %11\n\ts_nop 1"
                 : "=&v"(p[0]), "=&v"(p[1]), "=&v"(p[2]), "=&v"(p[3])
                 : "v"(x[8 * s]), "v"(x[8 * s + 1]), "v"(x[8 * s + 2]), "v"(x[8 * s + 3]), "v"(x[8 * s + 4]), "v"(x[8 * s + 5]), "v"(x[8 * s + 6]), "v"(x[8 * s + 7]));
    return __builtin_bit_cast(bf16x8, p);
}
template <int OFF> __device__ __forceinline__ s16x4 tr_read(unsigned addr) { s16x4 r; asm volatile("ds_read_b64_tr_b16 %0, %1 offset:%2" : "=&v"(r) : "v"(addr), "i"(OFF) : "memory"); return r; }
#define TR_WAIT() do { asm volatile("s_waitcnt lgkmcnt(0)" ::: "memory"); __builtin_amdgcn_sched_barrier(0); } while (0)
struct MixTensors {
    const bf16 *Q, *K, *V, *U, *G; bf16* MRG; const bf16* WS;
    const float *sinks, *vnorm, *bsp, *wsp, *cache_k, *cache_v, *sk_out, *sv_out; float* chunk_out; const float* ssqg;
};
#ifndef PROBE_SUB
#define PROBE_SUB 0
#endif

typedef float f32x2 __attribute__((ext_vector_type(2)));
template <int QT>
__device__ __forceinline__ void attn_tile(const MX_LAS bf16* Ks, const MX_LAS bf16* Vt  , const bf16x8 (&qf)[4], int kvh, int lane, int l31, int h, int kmin, float slope2, float sink2, f32x16 (&o)[2], float& ss_out) {
    const int lq = l31 - 4 * h; __builtin_assume(lq >= -4 && lq <= 31);
    const float nsl = -slope2, lterm = nsl * (float)lq;
    const int kmh = kmin - 4 * h;
    f32x16 s[5];
#pragma unroll
    for (int k5 = 0; k5 < 5; ++k5) { const int kt = QT + k5;
#pragma unroll
        for (int r = 0; r < 16; ++r) { const int klc = 32 * (QT + k5) + (r & 3) + 8 * (r >> 2); const int dist = (128 + 32 * QT - klc) + lq;
            const bool valid = (dist >= 0) && (dist < 128);
            s[k5][r] = valid ? __builtin_fmaf(nsl, (float)(128 + 32 * QT - klc), lterm) : -1e30f; }
        if (kmin > 0) {
#pragma unroll
            for (int r = 0; r < 16; ++r) { if (32 * (QT + k5) + (r & 3) + 8 * (r >> 2) < kmh) s[k5][r] = -1e30f; } }
#pragma unroll
        for (int ks = 0; ks < 4; ++ks) { const bf16x8 a = *(const MX_LAS bf16x8*)(Ks + (32 * kt + l31) * KS_STRIDE + kvh * 64 + 16 * ks + 8 * h); s[k5] = MX_MFMA(a, qf[ks], s[k5]); }
        __builtin_amdgcn_sched_barrier(0); }
    float mx = sink2;
#pragma unroll
    for (int k5 = 0; k5 < 5; ++k5)
#pragma unroll
        for (int r = 0; r < 16; ++r) mx = fmaxf(mx, s[k5][r]);
    mx = fmaxf(mx, __shfl_xor(mx, 32));
    f32x2 sum2 = {0.f, 0.f}; const f32x2 nmx = {-mx, -mx};
    bf16x8 pb[5][2];
#pragma unroll
    for (int k5 = 0; k5 < 5; ++k5) {
#pragma unroll
        for (int r = 0; r < 16; r += 2) { f32x2 d; d[0] = s[k5][r]; d[1] = s[k5][r + 1]; d = d + nmx; f32x2 p; p[0] = __builtin_amdgcn_exp2f(d[0]); p[1] = __builtin_amdgcn_exp2f(d[1]); s[k5][r] = p[0]; s[k5][r + 1] = p[1]; sum2 = sum2 + p; }
        pb[k5][0] = pack_step(s[k5], 0); pb[k5][1] = pack_step(s[k5], 1);
        __builtin_amdgcn_sched_barrier(0); }
    float sum = sum2[0] + sum2[1];
    sum += __shfl_xor(sum, 32); sum += __builtin_amdgcn_exp2f(sink2 - mx);
    const float inv = 1.0f / sum;
#pragma unroll
    for (int dt = 0; dt < 2; ++dt)
#pragma unroll
        for (int r = 0; r < 16; ++r) o[dt][r] = 0.f;
    const unsigned vaddr = (unsigned)(unsigned long)Vt + (unsigned)(((4 * h + ((lane >> 2) & 3)) * VR_STRIDE + kvh * 64 + 16 * ((lane >> 4) & 1) + 4 * (lane & 3)) * 2);
#define TRV(s2, dt, t) tr_read<((32 * (QT + K5) + 16 * (s2) + 8 * (t)) * VR_STRIDE + 32 * (dt)) * 2>(vaddr)
#define PV_TILE(K5_) do { constexpr int K5 = K5_; \
        const s16x4 a000 = TRV(0, 0, 0), a001 = TRV(0, 0, 1), a010 = TRV(0, 1, 0), a011 = TRV(0, 1, 1), a100 = TRV(1, 0, 0), a101 = TRV(1, 0, 1), a110 = TRV(1, 1, 0), a111 = TRV(1, 1, 1); \
        const bf16x8 pb0 = pb[K5][0], pb1 = pb[K5][1]; \
        TR_WAIT(); \
        o[0] = MX_MFMA(__builtin_shufflevector(a000, a001, 0, 1, 2, 3, 4, 5, 6, 7), pb0, o[0]); o[1] = MX_MFMA(__builtin_shufflevector(a010, a011, 0, 1, 2, 3, 4, 5, 6, 7), pb0, o[1]); \
        o[0] = MX_MFMA(__builtin_shufflevector(a100, a101, 0, 1, 2, 3, 4, 5, 6, 7), pb1, o[0]); o[1] = MX_MFMA(__builtin_shufflevector(a110, a111, 0, 1, 2, 3, 4, 5, 6, 7), pb1, o[1]); } while (0)
    PV_TILE(0); PV_TILE(1); PV_TILE(2); PV_TILE(3); PV_TILE(4);
#undef PV_TILE
#undef TRV
    f32x2 ss2 = {0.f, 0.f}; const f32x2 inv2 = {inv, inv};
#pragma unroll
    for (int dt = 0; dt < 2; ++dt)
#pragma unroll
        for (int r = 0; r < 16; r += 2) { f32x2 v; v[0] = o[dt][r]; v[1] = o[dt][r + 1]; v = v * inv2; o[dt][r] = v[0]; o[dt][r + 1] = v[1]; ss2 = v * v + ss2; }
    const float ss = ss2[0] + ss2[1];
    ss_out = ss + __shfl_xor(ss, 32);
}
__device__ __forceinline__ void attn_store(bf16* orow  , const f32x16 (&o)[2], float ra) {
#pragma unroll
    for (int dt = 0; dt < 2; ++dt)
#pragma unroll
        for (int g4 = 0; g4 < 4; ++g4) { u32x2 w2; w2.x = pk2(o[dt][4 * g4] * ra, o[dt][4 * g4 + 1] * ra); w2.y = pk2(o[dt][4 * g4 + 2] * ra, o[dt][4 * g4 + 3] * ra);
            *(u32x2*)(orow + 32 * dt + 8 * g4) = w2; }
}

template <int A> struct GateRegs { bf16x8 Bw[4 * (A + 1)]; float bias; u32x4 raw[8]; float rj[8]; u32x2 uu[4][4]; };
template <int A>
__device__ __forceinline__ void gate_issue(const MixTensors& T, size_t R0, int wid, GateRegs<A>& G) {
    const int lane = hw_lane();
    const int l31 = lane & 31, h = lane >> 5;
    constexpr int NKS = 4 * (A + 1);
    const int gg = wid >> 1, it = wid & 1;
    const unsigned C0 = (unsigned)R0 - 64u * (unsigned)A, prow = (unsigned)R0 + (unsigned)(32 * it + l31);
    const bf16* wrow = T.WS + ((unsigned)(gg * 128 + 64 * A + 32 * it + l31) * 128u + (unsigned)(8 * h));
#pragma unroll
    for (int ks = 0; ks < NKS; ++ks) G.Bw[ks] = *(const bf16x8*)(wrow + 16 * ks);
    G.bias = T.bsp[gg * 128 + 64 * A + 32 * it + l31];
#pragma unroll
    for (int q = 0; q < 8; ++q) { const int item = 128 * q + 64 * it + lane, j = item >> 4, cl = item & 15;
        G.raw[q] = *(const u32x4*)(T.G + ((C0 + (unsigned)j) * 512u + (unsigned)(gg * 128 + cl * 8))); G.rj[q] = T.ssqg[(C0 + (unsigned)j) * 4u + (unsigned)gg]; }
#pragma unroll
    for (int ct = 0; ct < 4; ++ct)
#pragma unroll
        for (int g4 = 0; g4 < 4; ++g4) G.uu[ct][g4] = *(const u32x2*)(T.U + (prow * 512u + (unsigned)(gg * 128 + 32 * ct + 8 * g4 + 4 * h)));
}
template <int A>
__device__ __forceinline__ void gate_part(MX_LAS unsigned char* lds, const MixTensors& T, size_t R0, int wid, GateRegs<A>& G) {
    MX_LAS float* SS2 = (MX_LAS float*)(lds + SS2_OFF);
    const int lane = hw_lane();
    const int l31 = lane & 31, h = lane >> 5;
    constexpr int NC = 8 * (A + 1), NKS = 4 * (A + 1);
    const int gg = wid >> 1, it = wid & 1;
    const unsigned C0 = (unsigned)R0 - 64u * (unsigned)A;
    MX_LAS bf16* Gr = (MX_LAS bf16*)(lds + gg * GT_BYTES);
    const float bias = G.bias;
#pragma unroll
    for (int q0 = 0; q0 < NC; q0 += 8) {
        u32x4 raw[8]; float rj[8];
#pragma unroll
        for (int q = 0; q < 8; ++q) { const int item = 128 * (q0 + q) + 64 * it + lane, j = item >> 4, cl = item & 15;
            if (q0 == 0) { raw[q] = G.raw[q]; rj[q] = G.rj[q]; }
            else { raw[q] = *(const u32x4*)(T.G + ((C0 + (unsigned)j) * 512u + (unsigned)(gg * 128 + cl * 8))); rj[q] = T.ssqg[(C0 + (unsigned)j) * 4u + (unsigned)gg]; } }
        __builtin_amdgcn_sched_barrier(0);
        const int cl = lane & 15;
        const MX_LAS f32x4* vn4 = (const MX_LAS f32x4*)((const MX_LAS float*)(lds + VN_OFF) + gg * 128 + cl * 8); const f32x4 va = vn4[0], vb = vn4[1];
#pragma unroll
        for (int q = 0; q < 8; ++q) { const int item = 128 * (q0 + q) + 64 * it + lane, j = item >> 4;
            const float r = __builtin_amdgcn_rsqf(rj[q] * (1.0f / 128.0f) + EPS);
            u32x4 w;
            w.x = pk2(bf2f(raw[q].x & 0xffffu) * r * va[0], bf2f(raw[q].x >> 16) * r * va[1]); w.y = pk2(bf2f(raw[q].y & 0xffffu) * r * va[2], bf2f(raw[q].y >> 16) * r * va[3]);
            w.z = pk2(bf2f(raw[q].z & 0xffffu) * r * vb[0], bf2f(raw[q].z >> 16) * r * vb[1]); w.w = pk2(bf2f(raw[q].w & 0xffffu) * r * vb[2], bf2f(raw[q].w >> 16) * r * vb[3]);
            *(MX_LAS u32x4*)(Gr + j * GR_STRIDE + cl * 8) = w; }
    }
    __syncthreads();
    f32x16 acc[4];
    const unsigned gaddr = (unsigned)(unsigned long)Gr + (unsigned)(((8 * h + ((lane >> 2) & 3)) * GR_STRIDE + 16 * ((lane >> 4) & 1) + 4 * (lane & 3)) * 2);
#define TRG(ct, ks, t) tr_read<((16 * (ks) + 4 * (t)) * GR_STRIDE + 32 * (ct)) * 2>(gaddr)
#define GATE_CT(CT) do { \
        s16x4 lo[NKS], hi[NKS]; \
        lo[0] = TRG(CT, 0, 0); hi[0] = TRG(CT, 0, 1); lo[1] = TRG(CT, 1, 0); hi[1] = TRG(CT, 1, 1); lo[2] = TRG(CT, 2, 0); hi[2] = TRG(CT, 2, 1); lo[3] = TRG(CT, 3, 0); hi[3] = TRG(CT, 3, 1); \
        if constexpr (NKS == 8) { lo[4] = TRG(CT, 4, 0); hi[4] = TRG(CT, 4, 1); lo[5] = TRG(CT, 5, 0); hi[5] = TRG(CT, 5, 1); lo[6] = TRG(CT, 6, 0); hi[6] = TRG(CT, 6, 1); lo[7] = TRG(CT, 7, 0); hi[7] = TRG(CT, 7, 1); } \
        TR_WAIT(); \
        _Pragma("unroll") for (int r = 0; r < 16; ++r) acc[CT][r] = 0.f; \
        _Pragma("unroll") for (int ks = 0; ks < NKS; ++ks) acc[CT] = MX_MFMA(__builtin_shufflevector(lo[ks], hi[ks], 0, 1, 2, 3, 4, 5, 6, 7), G.Bw[ks], acc[CT]); } while (0)
    GATE_CT(0); GATE_CT(1); GATE_CT(2); GATE_CT(3);
#undef GATE_CT
#undef TRG
    float gss = 0.f;
#pragma unroll
    for (int ct = 0; ct < 4; ++ct)
#pragma unroll
        for (int g4 = 0; g4 < 4; ++g4) {
            const float u0 = bf2f(G.uu[ct][g4].x & 0xffffu), u1 = bf2f(G.uu[ct][g4].x >> 16), u2 = bf2f(G.uu[ct][g4].y & 0xffffu), u3 = bf2f(G.uu[ct][g4].y >> 16);
            const float g0 = u0 * (acc[ct][4 * g4] + bias), g1 = u1 * (acc[ct][4 * g4 + 1] + bias), g2 = u2 * (acc[ct][4 * g4 + 2] + bias), g3 = u3 * (acc[ct][4 * g4 + 3] + bias);
            acc[ct][4 * g4] = g0; acc[ct][4 * g4 + 1] = g1; acc[ct][4 * g4 + 2] = g2; acc[ct][4 * g4 + 3] = g3; gss += (g0 * g0 + g1 * g1) + (g2 * g2 + g3 * g3); }
    gss += __shfl_xor(gss, 32);
    if (h == 0) SS2[wid * 32 + l31] = gss;
    __syncthreads();
    float tot = 0.f;
#pragma unroll
    for (int g2 = 0; g2 < 4; ++g2) tot += SS2[(2 * g2 + it) * 32 + l31];
    const float rg = __builtin_amdgcn_rsqf(tot * (1.0f / 512.0f) + EPS);
    MX_LAS bf16* GO = (MX_LAS bf16*)(lds + KS_OFF);
#pragma unroll
    for (int ct = 0; ct < 4; ++ct)
#pragma unroll
        for (int g4 = 0; g4 < 4; ++g4) { u32x2 w2; w2.x = pk2(acc[ct][4 * g4] * rg, acc[ct][4 * g4 + 1] * rg); w2.y = pk2(acc[ct][4 * g4 + 2] * rg, acc[ct][4 * g4 + 3] * rg);
            *(MX_LAS u32x2*)(GO + (32 * it + l31) * AO_STRIDE + gg * 128 + 32 * ct + 8 * g4 + 4 * h) = w2; }
    __syncthreads();
#pragma unroll
    for (int r8 = 0; r8 < 8; ++r8) { const int row = wid * 8 + r8;
        const u32x4 v = *(const MX_LAS u32x4*)(GO + row * AO_STRIDE + lane * 8); mrg_store(T.MRG, (((unsigned)R0 + (unsigned)row) * 1024u + (unsigned)(512 + lane * 8)) * 2u, v); }
    __syncthreads();
}

template <int A>
__device__ __forceinline__ void prompt_tail(MX_LAS unsigned char* lds, const MixTensors& T, size_t R0, int wid, const f32x16 (&o0)[2], const f32x16 (&o1)[2], float ss0, float ss1) {
    GateRegs<A> GR; gate_issue<A>(T, R0, wid, GR);
    __builtin_amdgcn_sched_barrier(0);
    const int lane = hw_lane(), l31 = lane & 31, h = lane >> 5; const int hh = wid;
    MX_LAS float* SS = (MX_LAS float*)(lds + SS_OFF);
    if (h == 0) { SS[wid * 64 + l31] = ss0; SS[wid * 64 + 32 + l31] = ss1; }
    __syncthreads();
    { MX_LAS bf16* AO = (MX_LAS bf16*)(lds + KS_OFF);
      float t0 = 0.f, t1 = 0.f;
#pragma unroll
      for (int w = 0; w < 8; ++w) { t0 += SS[w * 64 + l31]; t1 += SS[w * 64 + 32 + l31]; }
      const float ra0 = __builtin_amdgcn_rsqf(t0 * (1.0f / 512.0f) + EPS), ra1 = __builtin_amdgcn_rsqf(t1 * (1.0f / 512.0f) + EPS);
#pragma unroll
      for (int dt = 0; dt < 2; ++dt)
#pragma unroll
          for (int g4 = 0; g4 < 4; ++g4) { u32x2 w0, w1;
              w0.x = pk2(o0[dt][4 * g4] * ra0, o0[dt][4 * g4 + 1] * ra0); w0.y = pk2(o0[dt][4 * g4 + 2] * ra0, o0[dt][4 * g4 + 3] * ra0);
              w1.x = pk2(o1[dt][4 * g4] * ra1, o1[dt][4 * g4 + 1] * ra1); w1.y = pk2(o1[dt][4 * g4 + 2] * ra1, o1[dt][4 * g4 + 3] * ra1);
              *(MX_LAS u32x2*)(AO + l31 * AO_STRIDE + hh * 64 + 32 * dt + 8 * g4 + 4 * h) = w0; *(MX_LAS u32x2*)(AO + (32 + l31) * AO_STRIDE + hh * 64 + 32 * dt + 8 * g4 + 4 * h) = w1; }
      __syncthreads();
#pragma unroll
      for (int r8 = 0; r8 < 8; ++r8) { const int row = wid * 8 + r8;
          const u32x4 v = *(const MX_LAS u32x4*)(AO + row * AO_STRIDE + lane * 8); mrg_store(T.MRG, (((unsigned)R0 + (unsigned)row) * 1024u + (unsigned)(lane * 8)) * 2u, v); }
      __syncthreads(); }
    gate_part<A>(lds, T, R0, wid, GR);
}
__device__ __forceinline__ void prompt_unit(MX_LAS unsigned char* lds, const MixTensors& T, int b, int u64, int wid) {
    const int lane = hw_lane(), l31 = lane & 31, h = lane >> 5;
    const int t0 = u64 * 64; const size_t R0 = (size_t)b * 8192 + t0;
    MX_LAS bf16* Ks = (MX_LAS bf16*)(lds + KS_OFF); MX_LAS bf16* Vt = (MX_LAS bf16*)(lds + VT_OFF);
    MX_LAS float* SS = (MX_LAS float*)(lds + SS_OFF);
    const int hh = wid, kvh = hh >> 2;
    bf16x8 qf[2][4];
    const unsigned rowb = (unsigned)b * 8192u;
    { u32x4 kreg[6], vreg[6];
#pragma unroll
      for (int it = 0; it < 6; ++it) {
          const int idx = it * 512 + wid * 64 + lane, kr = idx >> 4, kc = idx & 15, kp = t0 - 128 + kr;
          const unsigned g = (rowb + (unsigned)(kp < 0 ? 0 : kp)) * 128u + (unsigned)(kc * 8);
          kreg[it] = *(const u32x4*)(T.K + g); vreg[it] = *(const u32x4*)(T.V + g);
          if (kp < 0) { kreg[it] = (u32x4){0u, 0u, 0u, 0u}; vreg[it] = (u32x4){0u, 0u, 0u, 0u}; } }
#pragma unroll
      for (int qt = 0; qt < 2; ++qt) { const bf16* qrow = T.Q + ((unsigned)R0 + (unsigned)(32 * qt + l31)) * 512u + (unsigned)(hh * 64 + 8 * h);
#pragma unroll
          for (int ks = 0; ks < 4; ++ks) qf[qt][ks] = *(const bf16x8*)(qrow + 16 * ks); }
#pragma unroll
      for (int it = 0; it < 6; ++it) { const int idx = it * 512 + wid * 64 + lane, kr = idx >> 4, kc = idx & 15;
          *(MX_LAS u32x4*)(Ks + kr * KS_STRIDE + kc * 8) = kreg[it]; *(MX_LAS u32x4*)(Vt + kr * VR_STRIDE + kc * 8) = vreg[it]; } }
    __syncthreads();
    const float slope2 = __builtin_amdgcn_exp2f(-(float)(hh + 1)) * LOG2E, sink2 = T.sinks[hh] * LOG2E;
    const int kmin = (t0 >= 128) ? 0 : 128 - t0;
    f32x16 o0[2], o1[2]; float ss0, ss1;
    attn_tile<0>(Ks, Vt, qf[0], kvh, lane, l31, h, kmin, slope2, sink2, o0, ss0);
    attn_tile<1>(Ks, Vt, qf[1], kvh, lane, l31, h, kmin, slope2, sink2, o1, ss1);
    if (u64 & 1) prompt_tail<1>(lds, T, R0, wid, o0, o1, ss0, ss1); else prompt_tail<0>(lds, T, R0, wid, o0, o1, ss0, ss1);
}

__device__ __forceinline__ void sample_unit(MX_LAS unsigned char* lds, const MixTensors& T, int s, int wid) {
    const int lane = hw_lane(), tid = wid * 64 + lane, l31 = lane & 31, h = lane >> 5;
    MX_LAS bf16* Ks = (MX_LAS bf16*)(lds + KS_OFF); MX_LAS bf16* Vt = (MX_LAS bf16*)(lds + VT_OFF);
    MX_LAS float* SB = (MX_LAS float*)(lds + SS_OFF);
    const int hh = wid, kvh = hh >> 2; const unsigned row0 = 16384u + 4u * (unsigned)s;
    bf16x8 qf[4];
    { const bf16* qrow = T.Q + (row0 + (unsigned)(l31 < 4 ? l31 : 3)) * 512u + (unsigned)(hh * 64 + 8 * h);
#pragma unroll
      for (int ks = 0; ks < 4; ++ks) qf[ks] = *(const bf16x8*)(qrow + 16 * ks); }
    { f32x4 kq[10];
#pragma unroll
      for (int q = 0; q < 10; ++q) { const int item = tid + 512 * q, row = item >> 5, c4 = item & 31, rr = row < 132 ? row : 131;
          const float* src = ((rr < 128) ? T.cache_k : T.sk_out) + ((unsigned)(s * 128 + (rr < 128 ? rr : rr - 4)) * 128u + (unsigned)(4 * c4));
          kq[q] = *(const f32x4*)src; }
      __builtin_amdgcn_sched_barrier(0);
#pragma unroll
      for (int q = 0; q < 10; ++q) { const int item = tid + 512 * q, row = item >> 5, c4 = item & 31; u32x2 w; if (row >= 132) kq[q] = (f32x4){0.f, 0.f, 0.f, 0.f}; w.x = pk2(kq[q][0], kq[q][1]); w.y = pk2(kq[q][2], kq[q][3]); *(MX_LAS u32x2*)(Ks + row * KS_STRIDE + 4 * c4) = w; } }
    { f32x4 vq[10];
#pragma unroll
      for (int q = 0; q < 10; ++q) { const int item = tid + 512 * q, row = item >> 5, c4 = item & 31, rr = row < 132 ? row : 131;
          const float* src = ((rr < 128) ? T.cache_v : T.sv_out) + ((unsigned)(s * 128 + (rr < 128 ? rr : rr - 4)) * 128u + (unsigned)(4 * c4));
          vq[q] = *(const f32x4*)src; }
      __builtin_amdgcn_sched_barrier(0);
#pragma unroll
      for (int q = 0; q < 10; ++q) { const int item = tid + 512 * q, row = item >> 5, c4 = item & 31; u32x2 w; if (row >= 132) vq[q] = (f32x4){0.f, 0.f, 0.f, 0.f};
          w.x = pk2(vq[q][0], vq[q][1]); w.y = pk2(vq[q][2], vq[q][3]); *(MX_LAS u32x2*)(Vt + row * VR_STRIDE + 4 * c4) = w; } }
    const int c = tid, gg = c >> 7;
    float gn[4], uv[4], wv[10], bv[4]; const float vnc = T.vnorm[c];
#pragma unroll
    for (int j = 0; j < 4; ++j) { gn[j] = bf2f(T.G[(row0 + j) * 512u + (unsigned)c]) * __builtin_amdgcn_rsqf(T.ssqg[(row0 + j) * 4u + (unsigned)gg] * (1.0f / 128.0f) + EPS) * vnc; uv[j] = bf2f(T.U[(row0 + j) * 512u + (unsigned)c]); bv[j] = T.bsp[gg * 128 + j]; }
#pragma unroll
    for (int i = 0, n = 0; i < 4; ++i)
#pragma unroll
        for (int j = 0; j <= i; ++j, ++n) wv[n] = T.wsp[(unsigned)(gg * 128 + i) * 128u + (unsigned)j];
    __syncthreads();
    const float slope2 = __builtin_amdgcn_exp2f(-(float)(hh + 1)) * LOG2E, sink2 = T.sinks[hh] * LOG2E;
    f32x16 o[2]; float ss;
    attn_tile<0>(Ks, Vt, qf, kvh, lane, l31, h, 0, slope2, sink2, o, ss);
    if (lane < 4) SB[wid * 4 + lane] = ss;
    float gate[4];
#pragma unroll
    for (int i = 0, n = 0; i < 4; ++i) { float mixed = bv[i];
#pragma unroll
        for (int j = 0; j <= i; ++j, ++n) mixed += wv[n] * gn[j];
        gate[i] = uv[i] * mixed; const float w = wave_sum(gate[i] * gate[i]); if (lane == 0) SB[64 + wid * 4 + i] = w;
        T.chunk_out[((unsigned)s * 4u + (unsigned)i) * 512u + (unsigned)c] = gn[i]; }
    __syncthreads();
    { float tot = 0.f;
#pragma unroll
      for (int w = 0; w < 8; ++w) tot += SB[w * 4 + (l31 & 3)];
      if (l31 < 4) attn_store(T.MRG + (row0 + (unsigned)l31) * 1024u + (unsigned)(hh * 64 + 4 * h), o, __builtin_amdgcn_rsqf(tot * (1.0f / 512.0f) + EPS)); }
#pragma unroll
    for (int i = 0; i < 4; ++i) { float tg = 0.f;
#pragma unroll
        for (int w = 0; w < 8; ++w) tg += SB[64 + w * 4 + i];
        T.MRG[(row0 + i) * 1024u + 512u + (unsigned)c] = (bf16)f2bf(gate[i] * __builtin_amdgcn_rsqf(tg * (1.0f / 512.0f) + EPS)); }
    __syncthreads();
}
__device__ __forceinline__ void mix_phase(MX_LAS unsigned char* lds, const MixTensors& T, int vcu, int G, int wid, int which = 3) {
    { const int lane0 = hw_lane(); ((MX_LAS float*)(lds + VN_OFF))[wid * 64 + lane0] = T.vnorm[wid * 64 + lane0]; }
    if (which & 1) for (int u = vcu; u < 256; u += G) prompt_unit(lds, T, u >> 7, u & 127, wid);
    if (which & 2) for (int rep = 0; rep < ((which & 4) ? 2 : 1); ++rep) for (int s = vcu; s < 128; s += G) sample_unit(lds, T, s, wid);
}
}

constexpr int NWAVES = 8;
#ifndef MK_N_LAUNCHES
#define MK_N_LAUNCHES 1
#endif
constexpr int N_PHASES = 8;
constexpr int N_LAUNCHES = MK_N_LAUNCHES;
static_assert(N_LAUNCHES == 1 || N_LAUNCHES == N_PHASES, "MK_N_LAUNCHES is 1 or 8");

constexpr int D = 1024, FF = 2816, NPROJ = 1792, MP = 16384, MS = 512, M = MP + MS;
constexpr size_t O_PK = (size_t)M * D, O_PV = O_PK + 2 * 128 * 128, O_SK = O_PV + 2 * 128 * 128, O_SV = O_SK + (size_t)128 * 128 * 128, O_CH = O_SV + (size_t)128 * 128 * 128, O_END = O_CH + (size_t)128 * 4 * 512;
constexpr size_t MiB = 1u << 20;
constexpr size_t WS_CTL = 0, CTL_ZERO_BYTES = 128 * 1024;   static_assert((8192 + 2 * 72 * 64) * 4 <= 128 * 1024, "CTL words inside the memset region");
constexpr size_t WS_SSQ = 1 * MiB;
constexpr size_t WS_WS = 2 * MiB;
constexpr size_t WS_W1GU = 3 * MiB, WS_W1D = 14 * MiB, WS_WIN = 20 * MiB, WS_WOUT = 24 * MiB, WS_W2GU = 26 * MiB, WS_W2D = 37 * MiB;
constexpr size_t WS_XB = 43 * MiB;
constexpr size_t WS_X12 = 76 * MiB;
constexpr size_t WS_H = 142 * MiB;
constexpr size_t WS_Q = WS_H, WS_K = WS_Q + (size_t)M * 512 * 2, WS_V = WS_K + (size_t)M * 128 * 2, WS_U = WS_V + (size_t)M * 128 * 2, WS_G = WS_U + (size_t)M * 512 * 2, WS_MRG = WS_G + (size_t)M * 512 * 2;
constexpr size_t WS_END = WS_H + (size_t)M * FF * 2;
static_assert(WS_MRG + (size_t)M * D * 2 <= WS_END && WS_END <= 256 * MiB, "d_ws map");
static_assert(WS_W1GU + (size_t)2 * FF * D * 2 <= WS_W1D && WS_W1D + (size_t)D * FF * 2 <= WS_WIN && WS_WIN + (size_t)NPROJ * D * 2 <= WS_WOUT && WS_WOUT + (size_t)D * D * 2 <= WS_W2GU && WS_W2GU + (size_t)2 * FF * D * 2 <= WS_W2D && WS_W2D + (size_t)D * FF * 2 <= WS_XB, "weights map");
static_assert(WS_XB + (size_t)M * D * 2 <= WS_X12 && WS_X12 + (size_t)M * D * 4 <= WS_H && WS_SSQ + (size_t)8 * M * 4 <= WS_SSQ + 768 * 1024, "activations map");
constexpr int CW_FIN = 8192;
constexpr int CW_BAR = 4096;
constexpr int RING_OFF = 0, RING_BYTES = 131072;
constexpr int LDS_BYTES = 163840;
constexpr int LDSCTL_OFF = LDS_BYTES - 1024, MISC_OFF = LDSCTL_OFF + 320;
static_assert(MISC_OFF + 128 <= LDS_BYTES && mixp::MIX_LDS_BYTES <= LDSCTL_OFF && RING_BYTES <= LDSCTL_OFF, "LDS map");

#define GAS __attribute__((address_space(1)))
#define LAS __attribute__((address_space(3)))
typedef unsigned short bf16;
typedef unsigned v4u __attribute__((ext_vector_type(4)));
typedef float f32x4 __attribute__((ext_vector_type(4)));
typedef GAS unsigned gu32;
#define RLX_AGENT __ATOMIC_RELAXED, __HIP_MEMORY_SCOPE_AGENT
#define LDS_WAIT() asm volatile("s_waitcnt lgkmcnt(0)" ::: "memory")
#define VM_WAIT() asm volatile("s_waitcnt vmcnt(0)" ::: "memory")
__device__ __forceinline__ unsigned f2bf(float f) { unsigned u = __builtin_bit_cast(unsigned, f); return (u + 0x7fffu + ((u >> 16) & 1u)) >> 16; }
__device__ __forceinline__ unsigned pk2(float lo, float hi) { unsigned r; asm volatile("v_cvt_pk_bf16_f32 %0, %1, %2" : "=v"(r) : "v"(lo), "v"(hi)); return r; }
#define XB_TMO      128
#define XB_XCNT(j)  (256  + 64 * (j))
#define XB_XSUB(j)  (1280 + 64 * (j))
#define XB_XGEN(j)  (2304 + 64 * (j))
#define XB_TOP      3328
#define XB_TOPGEN   3392
#define XCD_BAR_WORDS 3456
#define XB_SPIN_CAP (1u << 18)

__device__ __forceinline__ unsigned xb_ld(unsigned* p)              { return __hip_atomic_load(p, __ATOMIC_RELAXED, __HIP_MEMORY_SCOPE_AGENT); }
__device__ __forceinline__ unsigned xb_add(unsigned* p, unsigned v) { return __hip_atomic_fetch_add(p, v, __ATOMIC_RELAXED, __HIP_MEMORY_SCOPE_AGENT); }
__device__ __forceinline__ unsigned xb_xcc_id() { return (unsigned)__builtin_amdgcn_s_getreg((3 << 11) | 20) & 0xFu; }
#define XB_SPIN(cond, bar) do { unsigned _sp = 0; while (cond) { __builtin_amdgcn_s_sleep(1); \
    if ((++_sp & 255u) == 0u) { if (xb_ld(&(bar)[XB_TMO])) break; if (_sp > XB_SPIN_CAP) { atomicAdd(&(bar)[XB_TMO], 1u); break; } } } } while (0)

struct XcdBarrier {
    unsigned* bar; unsigned x;
    volatile LAS unsigned* st;
};

__device__ __forceinline__ XcdBarrier xcd_barrier_post(unsigned* bar, volatile LAS unsigned* st, bool leader  ) {
    XcdBarrier b; b.bar = bar; b.x = xb_xcc_id(); b.st = st;
    if (leader) (void)xb_add(&bar[XB_XCNT(b.x)], 1u);
    return b;
}
__device__ __forceinline__ void xcd_barrier_complete(unsigned* bar, unsigned x, unsigned& nloc, unsigned& nx) {
    const unsigned G = gridDim.x * gridDim.y * gridDim.z;
    unsigned sum, cnt, mine, sp = 0u;
    for (;;) {
        sum = 0u; cnt = 0u; mine = 0u;
#pragma unroll
        for (unsigned j = 0; j < 16; ++j) { const unsigned c = xb_ld(&bar[XB_XCNT(j)]); sum += c; cnt += (c > 0u) ? 1u : 0u; mine = (j == x) ? c : mine; }
        if (sum == G) break;
        __builtin_amdgcn_s_sleep(1);
        if ((++sp & 255u) == 0u) { if (xb_ld(&bar[XB_TMO])) break; if (sp > XB_SPIN_CAP) { atomicAdd(&bar[XB_TMO], 1u); break; } }
    }
    nloc = mine > 0u ? mine : 1u; nx = cnt > 0u ? cnt : 1u;
}

__device__ __forceinline__ void xcd_barrier(const XcdBarrier& b, bool leader  ) {
    asm volatile("s_waitcnt vmcnt(0)" ::: "memory");
    __syncthreads();
    if (leader) {
        unsigned* bar = b.bar;
        __builtin_amdgcn_s_waitcnt(0);
        unsigned nloc = b.st[0], nx = b.st[1];
        if (nloc == 0u) { xcd_barrier_complete(bar, b.x, nloc, nx); b.st[0] = nloc; b.st[1] = nx; }
        const unsigned old = xb_add(&bar[XB_XSUB(b.x)], 1u);
        const unsigned gen = old / nloc;
        if (old + 1u == (gen + 1u) * nloc) {
            __builtin_amdgcn_fence(__ATOMIC_RELEASE, "agent");
            asm volatile("s_waitcnt vmcnt(0)" ::: "memory");
            const unsigned og = xb_add(&bar[XB_TOP], 1u);
            const unsigned tg = og / nx;
            if (og + 1u == (tg + 1u) * nx) xb_add(&bar[XB_TOPGEN], 1u);
            else XB_SPIN(xb_ld(&bar[XB_TOPGEN]) == tg, bar);
            __builtin_amdgcn_fence(__ATOMIC_ACQUIRE, "agent");
            xb_add(&bar[XB_XGEN(b.x)], 1u);
            asm volatile("s_waitcnt vmcnt(0)" ::: "memory");
        } else {
            XB_SPIN(xb_ld(&bar[XB_XGEN(b.x)]) == gen, bar);
            __builtin_amdgcn_fence(__ATOMIC_ACQUIRE, "agent");
            asm volatile("s_waitcnt vmcnt(0)" ::: "memory");
        }
    }
    __syncthreads();
}

namespace skn {
#define SK_LAS __attribute__((address_space(3)))
typedef unsigned short bf16;
typedef short bf16x8 __attribute__((ext_vector_type(8)));
typedef float f32x4 __attribute__((ext_vector_type(4)));
typedef unsigned u32x2 __attribute__((ext_vector_type(2)));
constexpr int PSTRIDE = 36, PWAVE = 64 * PSTRIDE;
template <bool FINAL>
struct EpiResRow {
    bf16* XB; float* ssq; float scale; float* out; const float* gain; unsigned* cnt;
    __device__ __forceinline__ u32x2 prefetch(int row, int col) const { return *(const u32x2*)(XB + (size_t)row * 1024 + col); }
    __device__ __forceinline__ void operator()(int row, int col, const f32x4& v, int tid, int blk, const u32x2 bw) const {
        const size_t off = (size_t)row * 1024 + col;
        f32x4 o; o[0] = __uint_as_float(bw.x << 16) + v[0] * scale; o[1] = __uint_as_float(bw.x & 0xffff0000u) + v[1] * scale; o[2] = __uint_as_float(bw.y << 16) + v[2] * scale; o[3] = __uint_as_float(bw.y & 0xffff0000u) + v[3] * scale;
        if (!FINAL) { u32x2 w; w.x = pg8::cvt_pk_bf16(o[0], o[1]); w.y = pg8::cvt_pk_bf16(o[2], o[3]); *(u32x2*)(XB + off) = w; }
        float s = (o[0] * o[0] + o[1] * o[1]) + (o[2] * o[2] + o[3] * o[3]);
        s += __shfl_xor(s, 1); s += __shfl_xor(s, 2); s += __shfl_xor(s, 4);
        if ((tid & 7) == 0) atomicAdd(ssq + row, s);
        if (FINAL) {
            asm volatile("s_waitcnt vmcnt(0)" ::: "memory"); __syncthreads();
            unsigned* c = cnt + 64 * blk;
            if (tid == 0) __hip_atomic_fetch_add(c, 1u, __ATOMIC_RELAXED, __HIP_MEMORY_SCOPE_AGENT);
            if (tid < 64) for (unsigned polls = 0; (unsigned)__builtin_amdgcn_readfirstlane(__hip_atomic_load(c, __ATOMIC_RELAXED, __HIP_MEMORY_SCOPE_AGENT)) < 32u && polls < (1u << 20); ++polls) __builtin_amdgcn_s_sleep(2);
            __syncthreads();
            const float r = __builtin_amdgcn_rsqf(__hip_atomic_load(ssq + row, __ATOMIC_RELAXED, __HIP_MEMORY_SCOPE_AGENT) * (1.0f / 1024.0f) + 1e-6f);
            const f32x4 g = *(const f32x4*)(gain + col);
            *(f32x4*)(out + off) = o * r * g;
        }
    }
};
constexpr int STG_STRIDE = 72, STG_WAVE = 6 * 16 * STG_STRIDE;
template <int K, class EpiT>
__device__ __forceinline__ void skinny_phase(SK_LAS unsigned char* lds, const bf16* A, const bf16* Bt, int row_base, int vcu, int G, const EpiT& E, int wid) {
    const int lane = hw_lane(), tid = wid * 64 + lane;
    constexpr int NPT = K / 64, NPW = (NPT + 7) / 8, PBASE = NPT / 8, PREM = NPT % 8;
    static_assert(NPW <= 6 && 8 * STG_WAVE * 2 <= 131072, "skinny staging");
    const int npw = PBASE + (wid < PREM ? 1 : 0), pbeg = wid * PBASE + (wid < PREM ? wid : PREM);
    const int fr = lane & 15, fq = lane >> 4, r8 = lane >> 3, c8 = lane & 7;
    SK_LAS float* P = (SK_LAS float*)lds;
    SK_LAS bf16* SW = (SK_LAS bf16*)lds + wid * STG_WAVE;
    for (int tile = vcu; tile < 256; tile += G) {
        const int rt = tile & 7, ct = 4 * (tile >> 5) + ((tile >> 3) & 3);
        const int r0 = row_base + 64 * rt, c0 = 32 * ct;
        const u32x2 resid = E.prefetch(r0 + (tid >> 3), c0 + (tid & 7) * 4);
        f32x4 acc[4][2];
#pragma unroll
        for (int m = 0; m < 4; ++m)
#pragma unroll
            for (int n = 0; n < 2; ++n) acc[m][n] = (f32x4){0.f, 0.f, 0.f, 0.f};
        const bf16* apc = A + (size_t)(r0 + r8) * K + pbeg * 64 + 8 * c8; const bf16* bpc = Bt + (size_t)(c0 + r8) * K + pbeg * 64 + 8 * c8;
        bf16x8 ra[3][4][2], rb[3][2][2];
#define SK_LOAD(buf, q) do { const int qc_ = ((q) < npw ? (q) : npw - 1) * 64;     \
            _Pragma("unroll") for (int t = 0; t < 4; ++t) _Pragma("unroll") for (int i = 0; i < 2; ++i) ra[buf][t][i] = *(const bf16x8*)(apc + (size_t)(16 * t + 8 * i) * K + qc_); \
            _Pragma("unroll") for (int t = 0; t < 2; ++t) _Pragma("unroll") for (int i = 0; i < 2; ++i) rb[buf][t][i] = *(const bf16x8*)(bpc + (size_t)(16 * t + 8 * i) * K + qc_); } while (0)
#define SK_PAIR(buf, q) do { if ((q) < npw) {                         \
            _Pragma("unroll") for (int t = 0; t < 4; ++t) _Pragma("unroll") for (int i = 0; i < 2; ++i) *(SK_LAS bf16x8*)(SW + (t * 16 + 8 * i + r8) * STG_STRIDE + 8 * c8) = ra[buf][t][i]; \
            _Pragma("unroll") for (int t = 0; t < 2; ++t) _Pragma("unroll") for (int i = 0; i < 2; ++i) *(SK_LAS bf16x8*)(SW + ((4 + t) * 16 + 8 * i + r8) * STG_STRIDE + 8 * c8) = rb[buf][t][i]; \
            _Pragma("unroll") for (int s2 = 0; s2 < 2; ++s2) { bf16x8 fa[4], fb[2]; \
                _Pragma("unroll") for (int m = 0; m < 4; ++m) fa[m] = *(const SK_LAS bf16x8*)(SW + (m * 16 + fr) * STG_STRIDE + 8 * (4 * s2 + fq)); \
                _Pragma("unroll") for (int n = 0; n < 2; ++n) fb[n] = *(const SK_LAS bf16x8*)(SW + ((4 + n) * 16 + fr) * STG_STRIDE + 8 * (4 * s2 + fq)); \
                _Pragma("unroll") for (int m = 0; m < 4; ++m) _Pragma("unroll") for (int n = 0; n < 2; ++n) \
                    acc[m][n] = __builtin_amdgcn_mfma_f32_16x16x32_bf16(fb[n], fa[m], acc[m][n], 0, 0, 0); } } } while (0)
        SK_LOAD(0, 0); if (NPW > 1) SK_LOAD(1, 1); if (NPW > 2) SK_LOAD(2, 2);
        __builtin_amdgcn_sched_barrier(0);
#pragma unroll
        for (int q = 0; q < NPW; ++q) {
            if (q % 3 == 0) { SK_PAIR(0, q); __builtin_amdgcn_sched_barrier(0); if (q + 3 < NPW) SK_LOAD(0, q + 3); }
            else if (q % 3 == 1) { SK_PAIR(1, q); __builtin_amdgcn_sched_barrier(0); if (q + 3 < NPW) SK_LOAD(1, q + 3); }
            else { SK_PAIR(2, q); __builtin_amdgcn_sched_barrier(0); if (q + 3 < NPW) SK_LOAD(2, q + 3); }
            __builtin_amdgcn_sched_barrier(0);
        }
#undef SK_LOAD
#undef SK_PAIR
        __syncthreads();
#pragma unroll
        for (int m = 0; m < 4; ++m)
#pragma unroll
            for (int n = 0; n < 2; ++n) *(SK_LAS f32x4*)(P + wid * PWAVE + (16 * m + fr) * PSTRIDE + 16 * n + 4 * fq) = acc[m][n];
        __syncthreads();
        const int row = tid >> 3, c4 = (tid & 7) * 4;
        f32x4 s = (f32x4){0.f, 0.f, 0.f, 0.f};
#pragma unroll
        for (int w = 0; w < 8; ++w) s += *(const SK_LAS f32x4*)(P + w * PWAVE + row * PSTRIDE + c4);
        E(r0 + row, c0 + c4, s, tid, rt, resid);
        __syncthreads();
    }
}
}

struct Frame {
    LAS unsigned char* lds;
    volatile LAS unsigned* MISC;
    gu32* ctl;
    int wave, vcu, G;
};
__device__ __forceinline__ float wave_sum(float v) {
#pragma unroll
    for (int o = 1; o < 64; o <<= 1) v += __shfl_xor(v, o);
    return v;
}
struct TrItem { const float* W; const float* gain; bf16* WT; int K, N, gu, item; };
__device__ __forceinline__ void tr_load(const TrItem& d, int lane, f32x4 (&v)[8], float (&gv)[8]) {
    const int nblk = d.N / 32, kb = d.item / nblk, nb = d.item - kb * nblk, k0 = 64 * kb, n0 = 32 * nb;
#pragma unroll
    for (int i = 0; i < 8; ++i) { const int kk = i * 8 + (lane >> 3); v[i] = __builtin_nontemporal_load((const GAS f32x4*)(d.W + (size_t)(k0 + kk) * d.N + n0 + 4 * (lane & 7))); }
    if (d.gain) {
#pragma unroll
        for (int i = 0; i < 8; ++i) gv[i] = d.gain[k0 + i * 8 + (lane >> 3)];
    } else {
#pragma unroll
        for (int i = 0; i < 8; ++i) gv[i] = 1.0f; }
}
__device__ __forceinline__ void tr_finish(const TrItem& d, int lane, LAS float* scr, const f32x4 (&v)[8], const float (&gv)[8]) {
    const int nblk = d.N / 32, kb = d.item / nblk, nb = d.item - kb * nblk, k0 = 64 * kb, n0 = 32 * nb;
    const int drow0 = (d.gu == 0) ? n0 : 256 * (n0 >> 7) + (n0 & 127) + (d.gu == 2 ? 128 : 0);
#pragma unroll
    for (int i = 0; i < 8; ++i) { const int kk = i * 8 + (lane >> 3); LAS float* t = scr + kk * 33 + 4 * (lane & 7); t[0] = v[i].x * gv[i]; t[1] = v[i].y * gv[i]; t[2] = v[i].z * gv[i]; t[3] = v[i].w * gv[i]; }
    LDS_WAIT(); asm volatile("" ::: "memory");
    const int c = lane & 7;
#pragma unroll
    for (int j = 0; j < 4; ++j) { const int n = (lane >> 3) + 8 * j; const LAS float* t = scr + (8 * c) * 33 + n;
        v4u o; o.x = pk2(t[0 * 33], t[1 * 33]); o.y = pk2(t[2 * 33], t[3 * 33]); o.z = pk2(t[4 * 33], t[5 * 33]); o.w = pk2(t[6 * 33], t[7 * 33]);
        __builtin_amdgcn_raw_buffer_store_b128(o, __builtin_amdgcn_make_buffer_rsrc(d.WT, 0, 0x7fffffff, 0x00020000), (unsigned)(((size_t)(drow0 + n) * d.K + k0 + 8 * c) * 2), 0, 16); }
    LDS_WAIT(); asm volatile("" ::: "memory");
}
struct Args { const float* in[22]; float* out; unsigned char* ws; int ph_lo, ph_hi, li, pad; };
typedef const __attribute__((address_space(4))) Args* KArgs;
__device__ __forceinline__ KArgs kargs() { KArgs p = (KArgs)__builtin_amdgcn_kernarg_segment_ptr(); asm volatile("" : "+s"(p)); return p; }
enum { I_XP = 0, I_XS, I_CK, I_CV, I_N1, I_W1G, I_W1U, I_W1D, I_NM, I_WIN, I_SINK, I_VN, I_WSP, I_BSP, I_AON, I_GON, I_WOUT, I_N2, I_W2G, I_W2U, I_W2D, I_FN };

#ifndef MK_COPY_AUX
#define MK_COPY_AUX 16
#endif
__device__ __forceinline__ void cache_copy(const KArgs A, int which, int lane, int gw, int NGW) {
    const f32x4* src = (const f32x4*)A->in[which ? I_CV : I_CK]; f32x4* dst = (f32x4*)(A->out + (which ? O_SV : O_SK));
    constexpr int NCP = 128 * 3968;
    for (int idx0 = gw * 64 + lane; idx0 < NCP; idx0 += 4 * NGW * 64) { f32x4 a[4];
#pragma unroll
        for (int t = 0; t < 4; ++t) { int idx = idx0 + t * NGW * 64; idx = idx < NCP ? idx : NCP - 1; const int s = idx / 3968, r = idx - s * 3968; a[t] = src[(size_t)s * 4096 + 128 + r]; }
#pragma unroll
        for (int t = 0; t < 4; ++t) { const int idx = idx0 + t * NGW * 64; if (idx < NCP) { const int s = idx / 3968, r = idx - s * 3968; __builtin_amdgcn_raw_buffer_store_b128(__builtin_bit_cast(v4u, a[t]), __builtin_amdgcn_make_buffer_rsrc((void*)dst, 0, 0x7fffffff, 0x00020000), (unsigned)(((unsigned)s * 4096u + (unsigned)r) * 16u), 0, MK_COPY_AUX); } } }
}
constexpr int I_GU = (D / 64) * (FF / 32), I_DN = (FF / 64) * (D / 32), I_IN = (D / 64) * (NPROJ / 32), I_OUT = (D / 64) * (D / 32);
constexpr int W_P1 = 2 * I_GU, W_P3 = W_P1 + I_DN + I_IN + I_OUT, W_P6 = W_P3 + 2 * I_GU, W_END = W_P6 + I_DN;
__device__ __forceinline__ TrItem tr_item(const KArgs A, int it) {
    unsigned char* ws = A->ws; int r = it; TrItem d;
    if (r < I_GU) { d = TrItem{A->in[I_W1G], A->in[I_N1], (bf16*)(ws + WS_W1GU), D, FF, 1, r}; return d; } r -= I_GU;
    if (r < I_GU) { d = TrItem{A->in[I_W1U], A->in[I_N1], (bf16*)(ws + WS_W1GU), D, FF, 2, r}; return d; } r -= I_GU;
    if (r < I_DN) { d = TrItem{A->in[I_W1D], nullptr, (bf16*)(ws + WS_W1D), FF, D, 0, r}; return d; } r -= I_DN;
    if (r < I_IN) { d = TrItem{A->in[I_WIN], A->in[I_NM], (bf16*)(ws + WS_WIN), D, NPROJ, 0, r}; return d; } r -= I_IN;
    if (r < I_OUT) { const int k0 = 64 * (r / (D / 32)); d = TrItem{A->in[I_WOUT], (k0 < 512) ? A->in[I_AON] : A->in[I_GON] - 512, (bf16*)(ws + WS_WOUT), D, D, 0, r}; return d; } r -= I_OUT;
    if (r < I_GU) { d = TrItem{A->in[I_W2G], A->in[I_N2], (bf16*)(ws + WS_W2GU), D, FF, 1, r}; return d; } r -= I_GU;
    if (r < I_GU) { d = TrItem{A->in[I_W2U], A->in[I_N2], (bf16*)(ws + WS_W2GU), D, FF, 2, r}; return d; } r -= I_GU;
    d = TrItem{A->in[I_W2D], nullptr, (bf16*)(ws + WS_W2D), FF, D, 0, r}; return d;
}
__device__ __forceinline__ void weight_items(const KArgs A, LAS float* scr, int lane, int lo, int hi, int gw, int NGW) {
    int it = lo + gw; if (it >= hi) return;
    f32x4 va[8], vb[8]; float ga[8], gb[8];
    TrItem da = tr_item(A, it), db = da; tr_load(da, lane, va, ga);
    for (;;) {
        const bool more_b = it + NGW < hi; if (more_b) { db = tr_item(A, it + NGW); tr_load(db, lane, vb, gb); }
        tr_finish(da, lane, scr, va, ga);
        if (!more_b) break; it += NGW;
        const bool more_a = it + NGW < hi; if (more_a) { da = tr_item(A, it + NGW); tr_load(da, lane, va, ga); }
        tr_finish(db, lane, scr, vb, gb);
        if (!more_a) break; it += NGW;
    }
}
__device__ __forceinline__ void tril_items(const KArgs A, int lane, int gw, int NGW) {
    bf16* WSb = (bf16*)(A->ws + WS_WS); const float* wsp = A->in[I_WSP];
    for (int idx = gw * 64 + lane; idx < 4 * 128 * 128; idx += NGW * 64) { const int i = (idx >> 7) & 127, j = idx & 127; WSb[idx] = (bf16)((j <= i) ? f2bf(wsp[idx]) : 0u); }
}
__device__ __forceinline__ void deferred_weights(Frame& F, int nunits, int lo, int hi, bool with_tril, int copy_which = -1) {
    const int first_idle = nunits % F.G, c = (int)blockIdx.x;
    if (first_idle == 0 || c < first_idle) return;
    const KArgs A = kargs(); const int lane = hw_lane();
    LAS float* scr = (LAS float*)(F.lds + RING_OFF + F.wave * 16384);
    const int gw = (c - first_idle) * NWAVES + F.wave, NGW = (F.G - first_idle) * NWAVES;
    weight_items(A, scr, lane, lo, hi, gw, NGW);
    if (with_tril) tril_items(A, lane, gw, NGW);
    if (copy_which >= 0) cache_copy(A, copy_which, lane, gw, NGW);
}
__device__ __forceinline__ void p0_prologue(Frame& F) {
    const KArgs A = kargs();
    LAS float* scr = (LAS float*)(F.lds + RING_OFF + F.wave * 16384);
    const int lane = hw_lane();
    const int gw = F.vcu * NWAVES + F.wave, NGW = F.G * NWAVES;
    unsigned char* ws = A->ws;
#ifdef PROBE_PRETOUCH
    { const GAS f32x4* xp = (const GAS f32x4*)A->in[I_XP]; f32x4 accv = (f32x4){0.f, 0.f, 0.f, 0.f};
      for (int i0 = gw * 64 + lane; i0 < MP * D / 4; i0 += 8 * NGW * 64) { f32x4 t[8];
#pragma unroll
          for (int u = 0; u < 8; ++u) { int i = i0 + u * NGW * 64; i = i < MP * D / 4 ? i : MP * D / 4 - 1; t[u] = xp[i]; }
#pragma unroll
          for (int u = 0; u < 8; ++u) accv += t[u]; }
      asm volatile("" :: "v"(accv.x), "v"(accv.y), "v"(accv.z), "v"(accv.w)); }
#endif
    weight_items(A, scr, lane, 0, (N_LAUNCHES == 1 && F.G == 256) ? W_P1 : W_END, gw, NGW);
    if (!(N_LAUNCHES == 1 && F.G == 256)) tril_items(A, lane, gw, NGW);
    { bf16* XB = (bf16*)(ws + WS_XB); float* ssq = (float*)(ws + WS_SSQ);
      for (int m0 = gw; m0 < M; m0 += 2 * NGW) {
          f32x4 v[2][4]; float s[2];
#pragma unroll
          for (int t = 0; t < 2; ++t) { const int m = (m0 + t * NGW < M) ? m0 + t * NGW : m0;
              const float* xrow = (m < MP) ? A->in[I_XP] + (size_t)m * D : A->in[I_XS] + (size_t)(m - MP) * D; const GAS f32x4* xr = (const GAS f32x4*)xrow + lane;
#pragma unroll
              for (int j = 0; j < 4; ++j) v[t][j] = __builtin_nontemporal_load(xr + 64 * j); }
#pragma unroll
          for (int t = 0; t < 2; ++t) { const int m = m0 + t * NGW; s[t] = 0.f;
#pragma unroll
              for (int j = 0; j < 4; ++j) s[t] += (v[t][j].x * v[t][j].x + v[t][j].y * v[t][j].y) + (v[t][j].z * v[t][j].z + v[t][j].w * v[t][j].w);
              s[t] = wave_sum(s[t]);
              if (m < M) { GAS unsigned long long* o8 = (GAS unsigned long long*)(XB + (size_t)m * D) + lane;
#pragma unroll
                  for (int j = 0; j < 4; ++j) __hip_atomic_store((unsigned long long*)(o8 + 64 * j), (unsigned long long)pk2(v[t][j].x, v[t][j].y) | ((unsigned long long)pk2(v[t][j].z, v[t][j].w) << 32), __ATOMIC_RELAXED, __HIP_MEMORY_SCOPE_AGENT);
                  if (lane == 0) ssq[m] = s[t]; } } }
      for (int idx = gw * 64 + lane; idx < 7 * M; idx += NGW * 64) ssq[M + idx] = 0.f; }
    if (!(N_LAUNCHES == 1 && F.G == 256)) { cache_copy(A, 0, lane, gw, NGW); cache_copy(A, 1, lane, gw, NGW); }
}
#ifndef PROBE_DUP
#define PROBE_DUP -1
#endif
#define WSP(T, off) ((T*)(ws + (off)))
__device__ __forceinline__ void ph_ffn_up(Frame& F, int which, int rep) {
    const KArgs A = kargs(); unsigned char* ws = A->ws; float* ssq = WSP(float, WS_SSQ);
    pg8::Gemm g{WSP(const bf16, WS_XB), WSP(const bf16, which ? WS_W2GU : WS_W1GU), M, 2 * FF, D}; pg8::StaticOrder S; S.init(M, 2 * FF, F.G, (int)blockIdx.x);
    pg8::EpiSwiGLU E{WSP(bf16, WS_H), FF, ssq + (which ? 2 * M : 0)};
    pg8::gemm_phase<pg8::EpiSwiGLU, pg8::StaticOrder, true, true>(F.lds + RING_OFF, g, S, E, F.wave);
    if (N_LAUNCHES == 1 && F.G == 256 && rep == 0) { if (which == 0) deferred_weights(F, (M / 256) * (2 * FF / 256), W_P1, W_P3, true); else deferred_weights(F, (M / 256) * (2 * FF / 256), W_P6, W_END, false, 1); }
}
__device__ __forceinline__ void ph_ffn_down(Frame& F, int which, int rep) {
    const KArgs A = kargs(); unsigned char* ws = A->ws; float* ssq = WSP(float, WS_SSQ);
    float* sq = rep ? WSP(float, WS_SSQ + 768 * 1024) : ssq + (which ? 3 * M : M);
    pg8::Gemm g{WSP(const bf16, WS_H), WSP(const bf16, which ? WS_W2D : WS_W1D), MP, D, FF}; pg8::StaticOrder S; S.init(MP, D, F.G, (int)blockIdx.x);
    bf16* xb = rep ? WSP(bf16, WS_X12) : WSP(bf16, WS_XB);
    if (which == 0) { pg8::EpiRes E{xb, sq, 0.5f}; pg8::gemm_phase<pg8::EpiRes, pg8::StaticOrder, true, true>(F.lds + RING_OFF, g, S, E, F.wave);
        skn::EpiResRow<false> R{xb, sq, 0.5f, nullptr, nullptr, nullptr}; skn::skinny_phase<FF>(F.lds + RING_OFF, g.A, g.Bt, MP, F.vcu, F.G, R, F.wave);
#ifdef PROBE_SKINNY2
        { skn::EpiResRow<false> R2{WSP(bf16, WS_X12), WSP(float, WS_SSQ + 768 * 1024), 0.5f, nullptr, nullptr, nullptr}; skn::skinny_phase<FF>(F.lds + RING_OFF, g.A, g.Bt, MP, F.vcu, F.G, R2, F.wave); }
#endif
        }
    else { unsigned* cnt = (unsigned*)(ws + WS_CTL) + CW_FIN + (rep ? 72 * 64 : 0); float* outp = rep ? WSP(float, WS_X12) : A->out;
        pg8::EpiFinal E{WSP(const bf16, WS_XB), sq, 0.5f, outp, A->in[I_FN], cnt}; pg8::gemm_phase<pg8::EpiFinal, pg8::StaticOrder, true, true>(F.lds + RING_OFF, g, S, E, F.wave);
        skn::EpiResRow<true> R{WSP(bf16, WS_XB), sq, 0.5f, outp, A->in[I_FN], cnt + 64 * 64}; skn::skinny_phase<FF>(F.lds + RING_OFF, g.A, g.Bt, MP, F.vcu, F.G, R, F.wave); }
}
__device__ __forceinline__ void ph_proj(Frame& F, int rep = 0) {
    const KArgs A = kargs(); unsigned char* ws = A->ws; float* out = A->out;
    pg8::Gemm g{WSP(const bf16, WS_XB), WSP(const bf16, WS_WIN), M, NPROJ, D}; pg8::StaticOrder S; S.init(M, NPROJ, F.G, (int)blockIdx.x);
    pg8::EpiProj E{WSP(bf16, WS_Q), WSP(bf16, WS_K), WSP(bf16, WS_V), WSP(bf16, WS_U), WSP(bf16, WS_G), WSP(float, WS_SSQ) + M, out + O_PK, out + O_PV, out + O_SK, out + O_SV, rep ? WSP(float, WS_MRG) : WSP(float, WS_SSQ) + 4 * M};
    pg8::gemm_phase<pg8::EpiProj, pg8::StaticOrder, true, true>(F.lds + RING_OFF, g, S, E, F.wave);
    if (N_LAUNCHES == 1 && F.G == 256 && rep == 0) deferred_weights(F, (M / 256) * (NPROJ / 256), W_P3, W_P6, false);
}
__device__ __forceinline__ void ph_mix(Frame& F, int which = 3) {
    const KArgs A = kargs(); unsigned char* ws = A->ws; float* out = A->out;
    mixp::MixTensors T{WSP(const bf16, WS_Q), WSP(const bf16, WS_K), WSP(const bf16, WS_V), WSP(const bf16, WS_U), WSP(const bf16, WS_G), WSP(bf16, WS_MRG), WSP(const bf16, WS_WS),
                       A->in[I_SINK], A->in[I_VN], A->in[I_BSP], A->in[I_WSP], A->in[I_CK], A->in[I_CV], out + O_SK, out + O_SV, out + O_CH, WSP(float, WS_SSQ) + 4 * M};
    mixp::mix_phase(F.lds + RING_OFF, T, F.vcu, F.G, F.wave, which);
    if (N_LAUNCHES == 1 && F.G == 256 && which == 3 && F.vcu >= 128) cache_copy(A, 0, hw_lane(), (F.vcu - 128) * NWAVES + F.wave, 128 * NWAVES);
}
__device__ __forceinline__ void ph_out(Frame& F, int rep = 0) {
    const KArgs A = kargs(); unsigned char* ws = A->ws;
    pg8::Gemm g{WSP(const bf16, WS_MRG), WSP(const bf16, WS_WOUT), MP, D, D}; pg8::StaticOrder S; S.init(MP, D, F.G, (int)blockIdx.x);
    float* sq = rep ? WSP(float, WS_SSQ + 768 * 1024) : WSP(float, WS_SSQ) + 2 * M; bf16* xb = rep ? WSP(bf16, WS_X12) : WSP(bf16, WS_XB);
    pg8::EpiRes E{xb, sq, 1.0f};
    pg8::gemm_phase<pg8::EpiRes, pg8::StaticOrder, true, true>(F.lds + RING_OFF, g, S, E, F.wave);
    skn::EpiResRow<false> R{xb, sq, 1.0f, nullptr, nullptr, nullptr}; skn::skinny_phase<D>(F.lds + RING_OFF, g.A, g.Bt, MP, F.vcu, F.G, R, F.wave);
}
__global__ void __launch_bounds__(NWAVES * 64, 2) mk_fwd(Args args) {
    extern __shared__ __attribute__((aligned(16))) unsigned char lds[];
    Frame F;
    F.lds = (LAS unsigned char*)lds;
    F.MISC = (volatile LAS unsigned*)(F.lds + MISC_OFF);
    const int tid0 = threadIdx.x; F.wave = __builtin_amdgcn_readfirstlane(tid0 >> 6);
    F.G = gridDim.x; { const int bx = blockIdx.x; F.vcu = (F.G % 8 == 0) ? (bx % 8) * (F.G / 8) + bx / 8 : bx; }
    F.ctl = (gu32*)(kargs()->ws + WS_CTL);
    for (int u = tid0; u < (LDS_BYTES - LDSCTL_OFF) / 4; u += NWAVES * 64) ((LAS unsigned*)(F.lds + LDSCTL_OFF))[u] = 0u;
    __syncthreads();
    XcdBarrier bar; bar.bar = (unsigned*)(F.ctl + CW_BAR); bar.x = 0; bar.st = nullptr;
    if (N_LAUNCHES == 1) bar = xcd_barrier_post((unsigned*)(F.ctl + CW_BAR), F.MISC + 8, tid0 == 0);
#define GRID_BAR() do { if (N_LAUNCHES == 1) xcd_barrier(bar, F.wave == 0 && hw_lane() == 0); } while (0)
    const int lo = kargs()->ph_lo, hi = kargs()->ph_hi;
#define IN(k) (lo <= (k) && (k) < hi)
#define BOTH(k) (IN(k) && IN((k) + 1))
#define PHASE(k, call) do { if (IN(k)) { call; if (BOTH(k)) GRID_BAR(); } } while (0)
#define PHASE_DUP(k, call) do { if (PROBE_DUP == (k) && IN((k) > 9 ? (k) / 10 : (k))) { call; GRID_BAR(); } } while (0)
    PHASE(0, p0_prologue(F));                 PHASE_DUP(0, p0_prologue(F));
    PHASE(1, ph_ffn_up(F, 0, 0));             PHASE_DUP(1, ph_ffn_up(F, 0, 1));
    if (PROBE_DUP == 90) { GRID_BAR(); GRID_BAR(); GRID_BAR(); GRID_BAR(); }
    PHASE(2, ph_ffn_down(F, 0, 0));           PHASE_DUP(2, ph_ffn_down(F, 0, 1));
    PHASE(3, ph_proj(F));                     PHASE_DUP(3, ph_proj(F, 1));
    PHASE(4, ph_mix(F, PROBE_DUP == 43 ? 7 : 3));                      PHASE_DUP(4, ph_mix(F)); PHASE_DUP(41, ph_mix(F, 1)); PHASE_DUP(42, ph_mix(F, 2));
    PHASE(5, ph_out(F));                      PHASE_DUP(5, ph_out(F, 1));
    PHASE(6, ph_ffn_up(F, 1, 0));
    if (PROBE_DUP == 7 && IN(7)) { ph_ffn_down(F, 1, 1); GRID_BAR(); }
    if (IN(7)) ph_ffn_down(F, 1, 0);
#undef IN
#undef BOTH
}

extern "C" void kernel_launch(void* const* d_in, const int* in_sizes, int n_in, void* d_out, int out_size, void* d_ws, size_t ws_size, hipStream_t stream) {
    static int grid = 0;
    if (grid == 0) {
        if (n_in != 22 || in_sizes[0] != MP * D || (size_t)out_size != O_END || ws_size < WS_END) { fprintf(stderr, "kernel_launch: unexpected shapes (n_in %d, in0 %d, out %d, ws %zu); nothing launched\n", n_in, n_in > 0 ? in_sizes[0] : -1, out_size, ws_size); grid = -1; return; }
        int dev = 0, cus = 0, per_cu = 0;
        if (hipGetDevice(&dev) != hipSuccess || hipDeviceGetAttribute(&cus, hipDeviceAttributeMultiprocessorCount, dev) != hipSuccess) { grid = -1; return; }
        if (hipFuncSetAttribute((const void*)mk_fwd, hipFuncAttributeMaxDynamicSharedMemorySize, LDS_BYTES) != hipSuccess) { fprintf(stderr, "kernel_launch: hipFuncSetAttribute failed\n"); grid = -1; return; }
        if (hipOccupancyMaxActiveBlocksPerMultiprocessor(&per_cu, (const void*)mk_fwd, NWAVES * 64, LDS_BYTES) != hipSuccess || per_cu < 1) { fprintf(stderr, "kernel_launch: occupancy query failed (%d)\n", per_cu); (void)hipGetLastError(); per_cu = 1; }
        grid = cus;
    }
    if (grid < 0) return;
    if (hipMemsetAsync((char*)d_ws + WS_CTL, 0, CTL_ZERO_BYTES, stream) != hipSuccess) { fprintf(stderr, "kernel_launch: memset failed\n"); return; }
    Args a{};
    for (int i = 0; i < 22; ++i) a.in[i] = (const float*)d_in[i];
    a.out = (float*)d_out; a.ws = (unsigned char*)d_ws;
    if (N_LAUNCHES == 1) {
        a.ph_lo = 0; a.ph_hi = N_PHASES; a.li = 0;
        void* kargs[] = {&a};
#ifdef MK_PLAIN_LAUNCH
        (void)kargs; hipLaunchKernelGGL(mk_fwd, dim3(grid), dim3(NWAVES * 64), LDS_BYTES, stream, a);
#else
        hipError_t e = hipLaunchCooperativeKernel((const void*)mk_fwd, dim3(grid), dim3(NWAVES * 64), kargs, LDS_BYTES, stream);
        if (e != hipSuccess) fprintf(stderr, "kernel_launch: cooperative launch failed: %s (grid %d)\n", hipGetErrorString(e), grid);
#endif
    } else {
        for (int li = 0; li < N_PHASES; ++li) { a.ph_lo = li; a.ph_hi = li + 1; a.li = li;
            hipLaunchKernelGGL(mk_fwd, dim3(grid), dim3(NWAVES * 64), LDS_BYTES, stream, a); }
    }
}
```

```cpp
#include <hip/hip_runtime.h>
#include <cstdio>
#include <cstdint>
__device__ __forceinline__ int hw_lane() { int l = (int)__builtin_amdgcn_mbcnt_hi(~0u, __builtin_amdgcn_mbcnt_lo(~0u, 0u)); asm volatile("" : "+v"(l)); return l; }
namespace pg8 {
#define PG8_LAS __attribute__((address_space(3)))
typedef unsigned short bf16_t;
typedef short bf16x8 __attribute__((ext_vector_type(8)));
typedef float f32x4 __attribute__((ext_vector_type(4)));
typedef unsigned u32x4 __attribute__((ext_vector_type(4)));
constexpr int BM = 256, BK = 64, HALF = 128, HTB = HALF * BK * 2  , STAGE_BYTES = 8 * HTB, NXCD = 8, WGM = 4;

__host__ __device__ __forceinline__ int lds_byte(int r, int c) { const int st = (r >> 4) * 2 + (c >> 5), rr = r & 15, cc = c & 31, ob = rr * 64 + cc * 2; return st * 1024 + (ob ^ (((ob >> 9) & 1) << 5)); }
__host__ __device__ __forceinline__ void stage_rc(int b, int& R, int& C) { const int st = b / 1024, sb = b % 1024, swz = sb ^ (((sb >> 9) & 1) << 5); R = (st >> 1) * 16 + swz / 64; C = (st & 1) * 32 + (swz % 64) / 2; }
__host__ __device__ __forceinline__ int perm32(int rho) { const int n = rho >> 4, i = rho & 15; return 8 * (i >> 2) + 4 * n + (i & 3); }

struct Unit { int pm, pn; };
struct Gemm { const bf16_t* A; const bf16_t* Bt; int M, N, K; };

struct StaticOrder {
    int nM, nN, nwg, G, c;
    __host__ __device__ void init(int M, int N, int G_, int c_) { nM = M / BM; nN = N / BM; nwg = nM * nN; G = G_; c = c_; }
    __host__ __device__ bool next(int i, Unit& u) const {
        const long L = (long)i * G + c; if (L >= nwg) return false;
        int wgid = (int)L; { const int q = nwg / NXCD, r = nwg % NXCD, xcd = wgid % NXCD, off = wgid / NXCD; wgid = (xcd < r ? xcd * (q + 1) : r * (q + 1) + (xcd - r) * q) + off; }
        const int nig = WGM * nN, gid = wgid / nig, fm = gid * WGM, gsz = (nM - fm) < WGM ? (nM - fm) : WGM;
        u.pm = fm + ((wgid % nig) % gsz); u.pn = (wgid % nig) / gsz; return true;
    }
    __device__ __forceinline__ void a_ready(const Unit&) const {}
    __device__ __forceinline__ void done(const Unit&) const {}
};
__device__ __forceinline__ unsigned cvt_pk_bf16(float lo, float hi) { unsigned r; asm volatile("v_cvt_pk_bf16_f32 %0, %1, %2" : "=v"(r) : "v"(lo), "v"(hi)); return r; }
typedef float f32x2 __attribute__((ext_vector_type(2)));

constexpr float RMS_EPS_F = 1e-6f;
__device__ __forceinline__ float fast_sigmoid(float z) { return __builtin_amdgcn_rcpf(1.0f + __builtin_amdgcn_exp2f(-1.4426950408889634f * z)); }
__device__ __forceinline__ float silu_f(float x) { return x * fast_sigmoid(x); }
__device__ __forceinline__ float gelu_tanh_f(float x) { const float z = 1.5957691216057308f * (x + 0.044715f * x * x * x); return x * fast_sigmoid(z); }
#ifndef MK_WT_STORES
#define MK_WT_STORES 1
#endif
__device__ __forceinline__ void st16(void* base  , size_t elem_off  , const u32x4& v) {
#if MK_WT_STORES
    __builtin_amdgcn_raw_buffer_store_b128(v, __builtin_amdgcn_make_buffer_rsrc(base, 0, 0x7fffffff, 0x00020000), (unsigned)(elem_off * 2), 0, 16);
#else
    *(u32x4*)((bf16_t*)base + elem_off) = v;
#endif
}
#ifndef MK_Y_FULL
#define MK_Y_FULL 1
#endif
#ifndef MK_WT_Y
#define MK_WT_Y 1
#endif
#ifndef MK_Y_AUX
#define MK_Y_AUX 16
#endif
__device__ __forceinline__ void st16f(float* base  , size_t elem_off  , const f32x4& v) {
#if MK_WT_Y
    __builtin_amdgcn_raw_buffer_store_b128(__builtin_bit_cast(u32x4, v), __builtin_amdgcn_make_buffer_rsrc(base, 0, 0x7fffffff, 0x00020000), (unsigned)(elem_off * 4), 0, MK_Y_AUX);
#else
    *(f32x4*)(base + elem_off) = v;
#endif
}
__device__ __forceinline__ u32x4 pack8(const f32x4& a, const f32x4& b) { u32x4 w; w.x = cvt_pk_bf16(a[0], a[1]); w.y = cvt_pk_bf16(a[2], a[3]); w.z = cvt_pk_bf16(b[0], b[1]); w.w = cvt_pk_bf16(b[2], b[3]); return w; }

typedef float f32x2 __attribute__((ext_vector_type(2)));
__device__ __forceinline__ f32x2 swiglu2(const f32x2 g, const f32x2 u, const f32x2 c1, const f32x2 r2) {
    const f32x2 z = g * c1; f32x2 e; e[0] = __builtin_amdgcn_exp2f(z[0]); e[1] = __builtin_amdgcn_exp2f(z[1]);
    const f32x2 d = e + 1.0f; f32x2 s; s[0] = __builtin_amdgcn_rcpf(d[0]); s[1] = __builtin_amdgcn_rcpf(d[1]);
    return ((g * u) * r2) * s; }
__device__ __forceinline__ f32x2 gelu2(const f32x2 x) {
    constexpr float kc = -1.4426950408889634f * 1.5957691216057308f;
    const f32x2 p = (x * x) * (0.044715f * kc) + kc, z = x * p; f32x2 e; e[0] = __builtin_amdgcn_exp2f(z[0]); e[1] = __builtin_amdgcn_exp2f(z[1]);
    const f32x2 d = e + 1.0f; f32x2 s; s[0] = __builtin_amdgcn_rcpf(d[0]); s[1] = __builtin_amdgcn_rcpf(d[1]);
    return x * s; }
struct EpiSwiGLU {
    static constexpr bool PERM = true, AFTER_DRAIN = false;
    bf16_t* H; int ldh; const float* ssq;
    __device__ __forceinline__ void operator()(f32x4 (&acc)[2][2][4][2], const Unit& u, int wr, int wc, int fr, int fq) const {
        asm volatile("" : "+v"(fr), "+v"(fq));
        const int row0 = u.pm * BM + wr * 64 + fr, col0 = u.pn * 128 + wc * 32 + 8 * fq;
        float rs[2][4];
#pragma unroll
        for (int ai = 0; ai < 2; ++ai)
#pragma unroll
            for (int m = 0; m < 4; ++m) rs[ai][m] = ssq[row0 + ai * HALF + m * 16];
        __builtin_amdgcn_sched_barrier(0);
#pragma unroll
        for (int ai = 0; ai < 2; ++ai)
#pragma unroll
            for (int m = 0; m < 4; ++m) { const int row = row0 + ai * HALF + m * 16;
                const float r = __builtin_amdgcn_rsqf(rs[ai][m] * (1.0f / 1024.0f) + RMS_EPS_F), c1s = -1.4426950408889634f * r, r2s = r * r;
                const f32x2 c1 = {c1s, c1s}, r2 = {r2s, r2s};
                u32x4 w;
#pragma unroll
                for (int n = 0; n < 2; ++n) { const f32x4 G = acc[ai][0][m][n], U = acc[ai][1][m][n];
                    const f32x2 o0 = swiglu2(__builtin_shufflevector(G, G, 0, 1), __builtin_shufflevector(U, U, 0, 1), c1, r2), o1 = swiglu2(__builtin_shufflevector(G, G, 2, 3), __builtin_shufflevector(U, U, 2, 3), c1, r2);
                    w[2 * n] = cvt_pk_bf16(o0[0], o0[1]); w[2 * n + 1] = cvt_pk_bf16(o1[0], o1[1]); }
                st16(H, (size_t)row * ldh + col0, w); }
    }
};

__device__ __forceinline__ void unpack8(const u32x4& w, f32x4& a, f32x4& b) {
    a[0] = __uint_as_float(w.x << 16); a[1] = __uint_as_float(w.x & 0xffff0000u); a[2] = __uint_as_float(w.y << 16); a[3] = __uint_as_float(w.y & 0xffff0000u);
    b[0] = __uint_as_float(w.z << 16); b[1] = __uint_as_float(w.z & 0xffff0000u); b[2] = __uint_as_float(w.w << 16); b[3] = __uint_as_float(w.w & 0xffff0000u); }
struct EpiRes {
    static constexpr bool PERM = true, AFTER_DRAIN = false;
    bf16_t* XB; float* ssq; float scale;
    __device__ __forceinline__ void operator()(f32x4 (&acc)[2][2][4][2], const Unit& u, int wr, int wc, int fr, int fq) const {
        asm volatile("" : "+v"(fr), "+v"(fq));
        const int row0 = u.pm * BM + wr * 64 + fr, col0 = u.pn * BM + wc * 32 + 8 * fq;
#pragma unroll
        for (int ai = 0; ai < 2; ++ai) {
        u32x4 raw[4][2];
#pragma unroll
            for (int m = 0; m < 4; ++m)
#pragma unroll
                for (int bj = 0; bj < 2; ++bj) raw[m][bj] = *(const u32x4*)(XB + (size_t)(row0 + ai * HALF + m * 16) * 1024 + col0 + bj * HALF);
        __builtin_amdgcn_sched_barrier(0);
#pragma unroll
            for (int m = 0; m < 4; ++m) { const int row = row0 + ai * HALF + m * 16; const size_t off = (size_t)row * 1024 + col0; float s = 0.f;
#pragma unroll
                for (int bj = 0; bj < 2; ++bj) { f32x4 b0, b1; unpack8(raw[m][bj], b0, b1);
                    const f32x4 o0 = b0 + acc[ai][bj][m][0] * scale, o1 = b1 + acc[ai][bj][m][1] * scale;
                    st16(XB, off + bj * HALF, pack8(o0, o1));
                    s += (o0[0] * o0[0] + o0[1] * o0[1]) + (o0[2] * o0[2] + o0[3] * o0[3]) + (o1[0] * o1[0] + o1[1] * o1[1]) + (o1[2] * o1[2] + o1[3] * o1[3]); }
                s += __shfl_xor(s, 16); s += __shfl_xor(s, 32);
                if (fq == 0) atomicAdd(ssq + row, s); }
        __builtin_amdgcn_sched_barrier(0); }
    }
};
struct EpiFinal {
    static constexpr bool PERM = true, AFTER_DRAIN = false;
    const bf16_t* XB; float* ssq; float scale; float* out; const float* gain; unsigned* cnt;
    __device__ __forceinline__ void operator()(f32x4 (&acc)[2][2][4][2], const Unit& u, int wr, int wc, int fr, int fq) const {
        asm volatile("" : "+v"(fr), "+v"(fq));
        const int row0 = u.pm * BM + wr * 64 + fr, col0 = u.pn * BM + wc * 32 + 8 * fq;
#pragma unroll
        for (int ai = 0; ai < 2; ++ai) {
        u32x4 raw[4][2];
#pragma unroll
            for (int m = 0; m < 4; ++m)
#pragma unroll
                for (int bj = 0; bj < 2; ++bj) raw[m][bj] = *(const u32x4*)(XB + (size_t)(row0 + ai * HALF + m * 16) * 1024 + col0 + bj * HALF);
        __builtin_amdgcn_sched_barrier(0);
#pragma unroll
            for (int m = 0; m < 4; ++m) { const int row = row0 + ai * HALF + m * 16; float s = 0.f;
#pragma unroll
                for (int bj = 0; bj < 2; ++bj) { f32x4 b0, b1; unpack8(raw[m][bj], b0, b1);
                    const f32x4 o0 = b0 + acc[ai][bj][m][0] * scale, o1 = b1 + acc[ai][bj][m][1] * scale; acc[ai][bj][m][0] = o0; acc[ai][bj][m][1] = o1;
                    s += (o0[0] * o0[0] + o0[1] * o0[1]) + (o0[2] * o0[2] + o0[3] * o0[3]) + (o1[0] * o1[0] + o1[1] * o1[1]) + (o1[2] * o1[2] + o1[3] * o1[3]); }
                s += __shfl_xor(s, 16); s += __shfl_xor(s, 32);
                if (fq == 0) atomicAdd(ssq + row, s); }
        __builtin_amdgcn_sched_barrier(0); }
        f32x4 g[2][2];
#pragma unroll
        for (int bj = 0; bj < 2; ++bj) { g[bj][0] = *(const f32x4*)(gain + col0 + bj * HALF); g[bj][1] = *(const f32x4*)(gain + col0 + bj * HALF + 4); }
        asm volatile("s_waitcnt vmcnt(0)" ::: "memory");
        unsigned* c = cnt + 64 * u.pm;
        if (fr == 0 && fq == 0) __hip_atomic_fetch_add(c, 1u, __ATOMIC_RELAXED, __HIP_MEMORY_SCOPE_AGENT);
        for (unsigned polls = 0; (unsigned)__builtin_amdgcn_readfirstlane(__hip_atomic_load(c, __ATOMIC_RELAXED, __HIP_MEMORY_SCOPE_AGENT)) < 32u && polls < (1u << 20); ++polls) __builtin_amdgcn_s_sleep(2);
        float tot[2][4];
#pragma unroll
        for (int ai = 0; ai < 2; ++ai)
#pragma unroll
            for (int m = 0; m < 4; ++m) tot[ai][m] = __hip_atomic_load(ssq + row0 + ai * HALF + m * 16, __ATOMIC_RELAXED, __HIP_MEMORY_SCOPE_AGENT);
        __builtin_amdgcn_sched_barrier(0);
#ifndef MK_YDUP
#define MK_YDUP 1
#endif
#pragma unroll
        for (int ydup = 0; ydup < MK_YDUP; ++ydup) {
#pragma unroll
        for (int ai = 0; ai < 2; ++ai)
#pragma unroll
            for (int m = 0; m < 4; ++m) { const int row = row0 + ai * HALF + m * 16; const size_t off = (size_t)row * 1024 + col0;
                const float r = __builtin_amdgcn_rsqf(tot[ai][m] * (1.0f / 1024.0f) + RMS_EPS_F);
#pragma unroll
                for (int bj = 0; bj < 2; ++bj) {
#if MK_Y_FULL
                    const f32x4 p0 = acc[ai][bj][m][0] * r * g[bj][0], p1 = acc[ai][bj][m][1] * r * g[bj][1]; f32x4 dA, dB;
#pragma unroll
                    for (int j = 0; j < 4; ++j) {
                        dA[j] = __int_as_float(__builtin_amdgcn_update_dpp(__float_as_int(p0[j]), __float_as_int(p1[j]), 0x128  , 0xf, 0xc  , false));
                        dB[j] = __int_as_float(__builtin_amdgcn_update_dpp(__float_as_int(p1[j]), __float_as_int(p0[j]), 0x128, 0xf, 0x3  , false)); }
                    const int hf = (fr >> 3) & 1; const size_t offA = (size_t)(row - 8 * hf) * 1024 + col0 + bj * HALF + 4 * hf;
                    st16f(out, offA, dA); st16f(out, offA + 8 * 1024, dB);
#else
                    *(f32x4*)(out + off + bj * HALF) = acc[ai][bj][m][0] * r * g[bj][0]; *(f32x4*)(out + off + bj * HALF + 4) = acc[ai][bj][m][1] * r * g[bj][1];
#endif
                } }
        if (ydup + 1 < MK_YDUP) asm volatile("" ::: "memory"); }
    }
};

struct EpiProj {
    static constexpr bool PERM = true, AFTER_DRAIN = false;
    bf16_t *Q, *K, *V, *U, *G; const float* ssq; float *pk, *pv, *sk, *sv; float* ssqg;
    __device__ __forceinline__ void operator()(f32x4 (&acc)[2][2][4][2], const Unit& u, int wr, int wc, int fr, int fq) const {
        asm volatile("" : "+v"(fr), "+v"(fq));
        const int row0 = u.pm * BM + wr * 64 + fr, cw = wc * 32 + 8 * fq; const int pn = u.pn;
        float rs[2][4];
#pragma unroll
        for (int ai = 0; ai < 2; ++ai)
#pragma unroll
            for (int m = 0; m < 4; ++m) rs[ai][m] = ssq[row0 + ai * HALF + m * 16];
        __builtin_amdgcn_sched_barrier(0);
#pragma unroll
        for (int ai = 0; ai < 2; ++ai)
#pragma unroll
            for (int m = 0; m < 4; ++m) { const int row = row0 + ai * HALF + m * 16;
                const float r = __builtin_amdgcn_rsqf(rs[ai][m] * (1.0f / 1024.0f) + RMS_EPS_F);
#pragma unroll
                for (int bj = 0; bj < 2; ++bj) { f32x4 v0 = acc[ai][bj][m][0] * r, v1 = acc[ai][bj][m][1] * r;
                    if (pn < 2) { const float qs = 0.125f * 1.4426950408889634f; v0 = v0 * qs; v1 = v1 * qs;
                        st16(Q, (size_t)row * 512 + pn * 256 + bj * HALF + cw, pack8(v0, v1)); }
                    else if (pn == 2) { bf16_t* dst = bj ? V : K; st16(dst, (size_t)row * 128 + cw, pack8(v0, v1));
                        if (u.pm >= 64) { const unsigned sr = (unsigned)(row - 16384); float* fo = (bj ? sv : sk) + (((sr >> 2) * 128u + 124u + (sr & 3u)) * 128u + (unsigned)cw); *(f32x4*)fo = v0; *(f32x4*)(fo + 4) = v1; }
                        else if ((u.pm & 31) == 31 && ai == 1) { const unsigned w = (unsigned)(wr * 64 + m * 16 + fr); float* fo = (bj ? pv : pk) + (((unsigned)(u.pm >> 5) * 128u + w) * 128u + (unsigned)cw); *(f32x4*)fo = v0; *(f32x4*)(fo + 4) = v1; } }
                    else {
#pragma unroll
                        for (int h = 0; h < 2; ++h) { f32x4& v = h ? v1 : v0; const f32x2 a = gelu2(__builtin_shufflevector(v, v, 0, 1)), b = gelu2(__builtin_shufflevector(v, v, 2, 3)); v[0] = a[0]; v[1] = a[1]; v[2] = b[0]; v[3] = b[1]; }
                        bf16_t* dst = (pn < 5) ? U : G; const int ct = (pn < 5) ? pn - 3 : pn - 5;
                        st16(dst, (size_t)row * 512 + ct * 256 + bj * HALF + cw, pack8(v0, v1));
                        if (pn >= 5) { float s = (v0[0] * v0[0] + v0[1] * v0[1]) + (v0[2] * v0[2] + v0[3] * v0[3]) + (v1[0] * v1[0] + v1[1] * v1[1]) + (v1[2] * v1[2] + v1[3] * v1[3]);
                            s += __shfl_xor(s, 16); s += __shfl_xor(s, 32); if (fq == 0) atomicAdd(ssqg + (size_t)row * 4 + 2 * ct + bj, s); } } } }
    }
};
template <class Epi, class Sched, bool ALIGN_EPI = false, bool SP2 = false>
__device__ __forceinline__ void gemm_phase(PG8_LAS unsigned char* lds, const Gemm g, const Sched& S, const Epi& E, const int wid  ) {
    const int lane = hw_lane(), tid = wid * 64 + lane, wr = wid >> 2, wc = wid & 3, fr = lane & 15, fq = lane >> 4;
    const int K = g.K, nt = K / BK;
    unsigned voffA[2], voffB[2];
#pragma unroll
    for (int i = 0; i < 2; ++i) { int R, C; stage_rc(tid * 16 + i * 8192, R, C); const int Rb = Epi::PERM ? ((R & ~31) + perm32(R & 31)) : R;
        voffA[i] = (unsigned)(R * K + C) * 2u; voffB[i] = (unsigned)(Rb * K + C) * 2u; }
    const size_t kstep = (size_t)(BK * 2);
    const size_t hstep = (size_t)HALF * K * 2;
    const size_t tstep = 2 * hstep;
    const unsigned ldsw = (unsigned)wid * 1024u;
    const int aoff = lds_byte(wr * 64 + fr, fq * 8), boff = lds_byte(wc * 32 + fr, fq * 8);
#define PG8_SA(b, h) (((b) * 2 + (h)) * HTB)
#define PG8_SB(b, h) ((4 + (b) * 2 + (h)) * HTB)
#define PG8_STAGE(bufoff, gbase, voff) do { _Pragma("unroll") for (int _i = 0; _i < 2; ++_i) \
        __builtin_amdgcn_global_load_lds((const unsigned*)((const char*)(gbase) + (voff)[_i]), (PG8_LAS unsigned*)(lds + (bufoff) + ldsw + _i * 8192), 16, 0, 0); } while (0)
#define PG8_LDA(dst, b, h) do { _Pragma("unroll") for (int m = 0; m < 4; ++m) _Pragma("unroll") for (int k = 0; k < 2; ++k) dst[m][k] = *(const PG8_LAS bf16x8*)(lds + PG8_SA(b, h) + aoff + m * 2048 + k * 1024); } while (0)
#define PG8_LDB(dst, b, h) do { _Pragma("unroll") for (int n = 0; n < 2; ++n) _Pragma("unroll") for (int k = 0; k < 2; ++k) dst[n][k] = *(const PG8_LAS bf16x8*)(lds + PG8_SB(b, h) + boff + n * 2048 + k * 1024); } while (0)
#define PG8_MMA(ai, bj, At, Bt) do { __builtin_amdgcn_s_setprio(1); _Pragma("unroll") for (int m = 0; m < 4; ++m) _Pragma("unroll") for (int n = 0; n < 2; ++n) _Pragma("unroll") for (int k = 0; k < 2; ++k) \
        acc[ai][bj][m][n] = __builtin_amdgcn_mfma_f32_16x16x32_bf16(Bt[n][k], At[m][k], acc[ai][bj][m][n], 0, 0, 0); __builtin_amdgcn_s_setprio(0); } while (0)
#define PG8_WAIT_V(n) asm volatile("s_waitcnt vmcnt(" #n ")" ::: "memory")
#define PG8_WAIT_L(n) asm volatile("s_waitcnt lgkmcnt(" #n ")" ::: "memory")
#define PG8_BAR __builtin_amdgcn_s_barrier()
#define PG8_SCHED __builtin_amdgcn_sched_barrier(0)
    Unit cur, nxt; int ui = 0;
    if (!S.next(0, cur)) return;
    f32x4 acc[2][2][4][2];
#pragma unroll
    for (int a = 0; a < 2; ++a)
#pragma unroll
        for (int b = 0; b < 2; ++b)
#pragma unroll
            for (int m = 0; m < 4; ++m)
#pragma unroll
                for (int n = 0; n < 2; ++n) acc[a][b][m][n] = (f32x4){0.f, 0.f, 0.f, 0.f};
    bf16x8 At[4][2], B0[2][2], B1[2][2];
    const char* cA = (const char*)g.A + (size_t)cur.pm * tstep; const char* cB = (const char*)g.Bt + (size_t)cur.pn * tstep;
    S.a_ready(cur);
    if constexpr (SP2) {
        PG8_STAGE(PG8_SB(0, 0), cB, voffB); PG8_STAGE(PG8_SB(0, 1), cB + hstep, voffB); PG8_STAGE(PG8_SA(0, 0), cA, voffA); PG8_STAGE(PG8_SA(0, 1), cA + hstep, voffA);
        if (wr == 1) PG8_BAR;
        PG8_WAIT_V(2); PG8_BAR;
        PG8_STAGE(PG8_SB(1, 0), cB + kstep, voffB); PG8_STAGE(PG8_SA(1, 0), cA + kstep, voffA); PG8_STAGE(PG8_SB(1, 1), cB + hstep + kstep, voffB);
        PG8_WAIT_V(6); PG8_BAR;
    } else {
        PG8_STAGE(PG8_SB(0, 0), cB, voffB); PG8_STAGE(PG8_SA(0, 0), cA, voffA); PG8_STAGE(PG8_SB(0, 1), cB + hstep, voffB); PG8_STAGE(PG8_SA(0, 1), cA + hstep, voffA);
        if (wr == 1) PG8_BAR;
        PG8_WAIT_V(4); PG8_BAR;
        PG8_STAGE(PG8_SB(1, 0), cB + kstep, voffB); PG8_STAGE(PG8_SA(1, 0), cA + kstep, voffA); PG8_STAGE(PG8_SB(1, 1), cB + hstep + kstep, voffB);
        PG8_WAIT_V(6); PG8_BAR;
    }
    for (;;) {
        const bool has_next = S.next(ui + 1, nxt);
        const char* nA = has_next ? (const char*)g.A + (size_t)nxt.pm * tstep : cA; const char* nB = has_next ? (const char*)g.Bt + (size_t)nxt.pn * tstep : cB;
        for (int t = 0; t < nt; t += 2) {
            const bool last = (t == nt - 2);
            const char* a1 = cA + (size_t)(t + 1) * kstep;
            const char* a2 = last ? nA : cA + (size_t)(t + 2) * kstep; const char* b2 = last ? nB : cB + (size_t)(t + 2) * kstep;
            const char* a3 = a2 + kstep; const char* b3 = b2 + kstep;
            if (last && has_next) S.a_ready(nxt);
            if constexpr (SP2) {
            PG8_LDB(B0, 0, 0); PG8_LDB(B1, 0, 1); PG8_SCHED; PG8_LDA(At, 0, 0); PG8_STAGE(PG8_SA(1, 1), a1 + hstep, voffA);
            PG8_WAIT_V(8); PG8_WAIT_L(0); PG8_BAR; PG8_MMA(0, 0, At, B0); PG8_MMA(0, 1, At, B1); PG8_BAR; PG8_SCHED;
            PG8_LDA(At, 0, 1); PG8_STAGE(PG8_SB(0, 0), b2, voffB); PG8_STAGE(PG8_SB(0, 1), b2 + hstep, voffB); PG8_STAGE(PG8_SA(0, 0), a2, voffA);
            PG8_WAIT_V(8); PG8_WAIT_L(0); PG8_BAR; PG8_MMA(1, 0, At, B0); PG8_MMA(1, 1, At, B1); PG8_BAR; PG8_SCHED;
            PG8_LDB(B0, 1, 0); PG8_LDB(B1, 1, 1); PG8_SCHED; PG8_LDA(At, 1, 0); PG8_STAGE(PG8_SA(0, 1), a2 + hstep, voffA);
            PG8_WAIT_V(8); PG8_WAIT_L(0); PG8_BAR; PG8_MMA(0, 0, At, B0); PG8_MMA(0, 1, At, B1); PG8_BAR; PG8_SCHED;
            PG8_LDA(At, 1, 1); PG8_STAGE(PG8_SB(1, 0), b3, voffB); PG8_STAGE(PG8_SB(1, 1), b3 + hstep, voffB); PG8_STAGE(PG8_SA(1, 0), a3, voffA);
            PG8_WAIT_V(8); PG8_WAIT_L(0); PG8_BAR; PG8_MMA(1, 0, At, B0); PG8_MMA(1, 1, At, B1); PG8_BAR; PG8_SCHED;
            } else {
            PG8_LDB(B0, 0, 0); PG8_SCHED; PG8_LDA(At, 0, 0); PG8_STAGE(PG8_SA(1, 1), a1 + hstep, voffA);
            PG8_WAIT_L(8); PG8_BAR; PG8_WAIT_L(0); PG8_MMA(0, 0, At, B0); PG8_BAR; PG8_SCHED;
            PG8_LDB(B1, 0, 1); PG8_STAGE(PG8_SB(0, 0), b2, voffB);
            PG8_BAR; PG8_WAIT_L(0); PG8_MMA(0, 1, At, B1); PG8_BAR;
            PG8_LDA(At, 0, 1); PG8_STAGE(PG8_SA(0, 0), a2, voffA);
            PG8_BAR; PG8_WAIT_L(0); PG8_MMA(1, 0, At, B0); PG8_BAR; PG8_SCHED;
            PG8_STAGE(PG8_SB(0, 1), b2 + hstep, voffB);
            PG8_WAIT_V(6); PG8_BAR; PG8_MMA(1, 1, At, B1); PG8_BAR;
            PG8_LDB(B0, 1, 0); PG8_SCHED; PG8_LDA(At, 1, 0); PG8_STAGE(PG8_SA(0, 1), a2 + hstep, voffA);
            PG8_WAIT_L(8); PG8_BAR; PG8_WAIT_L(0); PG8_MMA(0, 0, At, B0); PG8_BAR; PG8_SCHED;
            PG8_LDB(B1, 1, 1); PG8_STAGE(PG8_SB(1, 0), b3, voffB);
            PG8_BAR; PG8_WAIT_L(0); PG8_MMA(0, 1, At, B1); PG8_BAR;
            PG8_LDA(At, 1, 1); PG8_STAGE(PG8_SA(1, 0), a3, voffA);
            PG8_BAR; PG8_WAIT_L(0); PG8_MMA(1, 0, At, B0); PG8_BAR; PG8_SCHED;
            PG8_STAGE(PG8_SB(1, 1), b3 + hstep, voffB);
            PG8_WAIT_V(6); PG8_BAR; PG8_MMA(1, 1, At, B1); PG8_BAR;
            }
        }
        if constexpr (ALIGN_EPI) { if (wr == 0) PG8_BAR; }
        if constexpr (!Epi::AFTER_DRAIN) { E(acc, cur, wr, wc, fr, fq); S.done(cur); }
        if (!has_next) break;
#pragma unroll
        for (int a = 0; a < 2; ++a)
#pragma unroll
            for (int b = 0; b < 2; ++b)
#pragma unroll
                for (int m = 0; m < 4; ++m)
#pragma unroll
                    for (int n = 0; n < 2; ++n) acc[a][b][m][n] = (f32x4){0.f, 0.f, 0.f, 0.f};
        cur = nxt; cA = nA; cB = nB; ++ui;
        if constexpr (ALIGN_EPI) { if (wr == 1) PG8_BAR; }
    }
    PG8_WAIT_V(0);
    if constexpr (!ALIGN_EPI) { if (wr == 0) PG8_BAR; }
    PG8_BAR;
    if constexpr (Epi::AFTER_DRAIN) { E.fused(acc, cur, wr, wc, fr, fq, lds, wid, lane); S.done(cur); }
#undef PG8_SA
#undef PG8_SB
#undef PG8_STAGE
#undef PG8_LDA
#undef PG8_LDB
#undef PG8_MMA
#undef PG8_WAIT_V
#undef PG8_WAIT_L
#undef PG8_BAR
#undef PG8_SCHED
}
}

namespace mixp {
#define MX_LAS __attribute__((address_space(3)))
typedef unsigned short bf16;
typedef short bf16x8 __attribute__((ext_vector_type(8)));
typedef short s16x4 __attribute__((ext_vector_type(4)));
typedef float f32x16 __attribute__((ext_vector_type(16)));
typedef float f32x4 __attribute__((ext_vector_type(4)));
typedef unsigned u32x4 __attribute__((ext_vector_type(4)));
typedef unsigned u32x2 __attribute__((ext_vector_type(2)));
constexpr float LOG2E = 1.4426950408889634f, EPS = 1e-6f;
constexpr int KS_STRIDE = 136, VR_STRIDE = 144, GT_STRIDE = 136, AO_STRIDE = 520;
constexpr int GR_STRIDE = 144;
constexpr int KS_OFF = 0, VT_OFF = 192 * KS_STRIDE * 2, GT_BYTES = 128 * GR_STRIDE * 2;
constexpr int SS2_OFF = 4 * GT_BYTES, SS_OFF = SS2_OFF + 1024, VN_OFF = SS_OFF + 2048, MIX_LDS_BYTES = VN_OFF + 2048;
static_assert(VT_OFF == 52224 && VT_OFF + 192 * VR_STRIDE * 2 <= SS2_OFF && SS2_OFF == 147456, "mixer LDS map");
#define MX_MFMA(a, b, c) __builtin_amdgcn_mfma_f32_32x32x16_bf16((a), (b), (c), 0, 0, 0)
#ifndef MK_MRG_WT
#define MK_MRG_WT 1
#endif
__device__ __forceinline__ void mrg_store(bf16* base, unsigned byte_off, const u32x4& v) {
#if MK_MRG_WT
    __builtin_amdgcn_raw_buffer_store_b128(v, __builtin_amdgcn_make_buffer_rsrc((void*)base, 0, 0x7fffffff, 0x00020000), byte_off, 0, 16);
#else
    *(u32x4*)((unsigned char*)base + byte_off) = v;
#endif
}
__device__ __forceinline__ float bf2f(unsigned b) { return __uint_as_float(b << 16); }
__device__ __forceinline__ unsigned f2bf(float f) { unsigned u = __float_as_uint(f); return (u + 0x7fffu + ((u >> 16) & 1u)) >> 16; }
__device__ __forceinline__ unsigned pk2(float lo, float hi) { unsigned r; asm volatile("v_cvt_pk_bf16_f32 %0, %1, %2" : "=v"(r) : "v"(lo), "v"(hi)); return r; }
__device__ __forceinline__ float wave_sum(float v) {
#pragma unroll
    for (int o = 1; o < 64; o <<= 1) v += __shfl_xor(v, o);
    return v; }
__device__ __forceinline__ float wave_max(float v) {
#pragma unroll
    for (int o = 1; o < 64; o <<= 1) v = fmaxf(v, __shfl_xor(v, o));
    return v; }
__device__ __forceinline__ bf16x8 pack_step(const f32x16& x, int s) {
    u32x4 p;
    asm volatile("v_cvt_pk_bf16_f32 %0, %4, %5\n\tv_cvt_pk_bf16_f32 %1, %6, %7\n\tv_cvt_pk_bf16_f32 %2, %8, %9\n\tv_cvt_pk_bf16_f32 %3, %10, %11\n\ts_nop 1"
                 : "=&v"(p[0]), "=&v"(p[1]), "=&v"(p[2]), "=&v"(p[3])
                 : "v"(x[8 * s]), "v"(x[8 * s + 1]), "v"(x[8 * s + 2]), "v"(x[8 * s + 3]), "v"(x[8 * s + 4]), "v"(x[8 * s + 5]), "v"(x[8 * s + 6]), "v"(x[8 * s + 7]));
    return __builtin_bit_cast(bf16x8, p);
}
template <int OFF> __device__ __forceinline__ s16x4 tr_read(unsigned addr) { s16x4 r; asm volatile("ds_read_b64_tr_b16 %0, %1 offset:%2" : "=&v"(r) : "v"(addr), "i"(OFF) : "memory"); return r; }
#define TR_WAIT() do { asm volatile("s_waitcnt lgkmcnt(0)" ::: "memory"); __builtin_amdgcn_sched_barrier(0); } while (0)
struct MixTensors {
    const bf16 *Q, *K, *V, *U, *G; bf16* MRG; const bf16* WS;
    const float *sinks, *vnorm, *bsp, *wsp, *cache_k, *cache_v, *sk_out, *sv_out; float* chunk_out; const float* ssqg;
};
#ifndef PROBE_SUB
#define PROBE_SUB 0
#endif

typedef float f32x2 __attribute__((ext_vector_type(2)));
template <int QT>
__device__ __forceinline__ void attn_tile(const MX_LAS bf16* Ks, const MX_LAS bf16* Vt  , const bf16x8 (&qf)[4], int kvh, int lane, int l31, int h, int kmin, float slope2, float sink2, f32x16 (&o)[2], float& ss_out) {
    const int lq = l31 - 4 * h; __builtin_assume(lq >= -4 && lq <= 31);
    const float nsl = -slope2, lterm = nsl * (float)lq;
    const int kmh = kmin - 4 * h;
    f32x16 s[5];
#pragma unroll
    for (int k5 = 0; k5 < 5; ++k5) { const int kt = QT + k5;
#pragma unroll
        for (int r = 0; r < 16; ++r) { const int klc = 32 * (QT + k5) + (r & 3) + 8 * (r >> 2); const int dist = (128 + 32 * QT - klc) + lq;
            const bool valid = (dist >= 0) && (dist < 128);
            s[k5][r] = valid ? __builtin_fmaf(nsl, (float)(128 + 32 * QT - klc), lterm) : -1e30f; }
        if (kmin > 0) {
#pragma unroll
            for (int r = 0; r < 16; ++r) { if (32 * (QT + k5) + (r & 3) + 8 * (r >> 2) < kmh) s[k5][r] = -1e30f; } }
#pragma unroll
        for (int ks = 0; ks < 4; ++ks) { const bf16x8 a = *(const MX_LAS bf16x8*)(Ks + (32 * kt + l31) * KS_STRIDE + kvh * 64 + 16 * ks + 8 * h); s[k5] = MX_MFMA(a, qf[ks], s[k5]); }
        __builtin_amdgcn_sched_barrier(0); }
    float mx = sink2;
#pragma unroll
    for (int k5 = 0; k5 < 5; ++k5)
#pragma unroll
        for (int r = 0; r < 16; ++r) mx = fmaxf(mx, s[k5][r]);
    mx = fmaxf(mx, __shfl_xor(mx, 32));
    f32x2 sum2 = {0.f, 0.f}; const f32x2 nmx = {-mx, -mx};
    bf16x8 pb[5][2];
#pragma unroll
    for (int k5 = 0; k5 < 5; ++k5) {
#pragma unroll
        for (int r = 0; r < 16; r += 2) { f32x2 d; d[0] = s[k5][r]; d[1] = s[k5][r + 1]; d = d + nmx; f32x2 p; p[0] = __builtin_amdgcn_exp2f(d[0]); p[1] = __builtin_amdgcn_exp2f(d[1]); s[k5][r] = p[0]; s[k5][r + 1] = p[1]; sum2 = sum2 + p; }
        pb[k5][0] = pack_step(s[k5], 0); pb[k5][1] = pack_step(s[k5], 1);
        __builtin_amdgcn_sched_barrier(0); }
    float sum = sum2[0] + sum2[1];
    sum += __shfl_xor(sum, 32); sum += __builtin_amdgcn_exp2f(sink2 - mx);
    const float inv = 1.0f / sum;
#pragma unroll
    for (int dt = 0; dt < 2; ++dt)
#pragma unroll
        for (int r = 0; r < 16; ++r) o[dt][r] = 0.f;
    const unsigned vaddr = (unsigned)(unsigned long)Vt + (unsigned)(((4 * h + ((lane >> 2) & 3)) * VR_STRIDE + kvh * 64 + 16 * ((lane >> 4) & 1) + 4 * (lane & 3)) * 2);
#define TRV(s2, dt, t) tr_read<((32 * (QT + K5) + 16 * (s2) + 8 * (t)) * VR_STRIDE + 32 * (dt)) * 2>(vaddr)
#define PV_TILE(K5_) do { constexpr int K5 = K5_; \
        const s16x4 a000 = TRV(0, 0, 0), a001 = TRV(0, 0, 1), a010 = TRV(0, 1, 0), a011 = TRV(0, 1, 1), a100 = TRV(1, 0, 0), a101 = TRV(1, 0, 1), a110 = TRV(1, 1, 0), a111 = TRV(1, 1, 1); \
        const bf16x8 pb0 = pb[K5][0], pb1 = pb[K5][1]; \
        TR_WAIT(); \
        o[0] = MX_MFMA(__builtin_shufflevector(a000, a001, 0, 1, 2, 3, 4, 5, 6, 7), pb0, o[0]); o[1] = MX_MFMA(__builtin_shufflevector(a010, a011, 0, 1, 2, 3, 4, 5, 6, 7), pb0, o[1]); \
        o[0] = MX_MFMA(__builtin_shufflevector(a100, a101, 0, 1, 2, 3, 4, 5, 6, 7), pb1, o[0]); o[1] = MX_MFMA(__builtin_shufflevector(a110, a111, 0, 1, 2, 3, 4, 5, 6, 7), pb1, o[1]); } while (0)
    PV_TILE(0); PV_TILE(1); PV_TILE(2); PV_TILE(3); PV_TILE(4);
#undef PV_TILE
#undef TRV
    f32x2 ss2 = {0.f, 0.f}; const f32x2 inv2 = {inv, inv};
#pragma unroll
    for (int dt = 0; dt < 2; ++dt)
#pragma unroll
        for (int r = 0; r < 16; r += 2) { f32x2 v; v[0] = o[dt][r]; v[1] = o[dt][r + 1]; v = v * inv2; o[dt][r] = v[0]; o[dt][r + 1] = v[1]; ss2 = v * v + ss2; }
    const float ss = ss2[0] + ss2[1];
    ss_out = ss + __shfl_xor(ss, 32);
}
__device__ __forceinline__ void attn_store(bf16* orow  , const f32x16 (&o)[2], float ra) {
#pragma unroll
    for (int dt = 0; dt < 2; ++dt)
#pragma unroll
        for (int g4 = 0; g4 < 4; ++g4) { u32x2 w2; w2.x = pk2(o[dt][4 * g4] * ra, o[dt][4 * g4 + 1] * ra); w2.y = pk2(o[dt][4 * g4 + 2] * ra, o[dt][4 * g4 + 3] * ra);
            *(u32x2*)(orow + 32 * dt + 8 * g4) = w2; }
}

template <int A> struct GateRegs { bf16x8 Bw[4 * (A + 1)]; float bias; u32x4 raw[8]; float rj[8]; u32x2 uu[4][4]; };
template <int A>
__device__ __forceinline__ void gate_issue(const MixTensors& T, size_t R0, int wid, GateRegs<A>& G) {
    const int lane = hw_lane();
    const int l31 = lane & 31, h = lane >> 5;
    constexpr int NKS = 4 * (A + 1);
    const int gg = wid >> 1, it = wid & 1;
    const unsigned C0 = (unsigned)R0 - 64u * (unsigned)A, prow = (unsigned)R0 + (unsigned)(32 * it + l31);
    const bf16* wrow = T.WS + ((unsigned)(gg * 128 + 64 * A + 32 * it + l31) * 128u + (unsigned)(8 * h));
#pragma unroll
    for (int ks = 0; ks < NKS; ++ks) G.Bw[ks] = *(const bf16x8*)(wrow + 16 * ks);
    G.bias = T.bsp[gg * 128 + 64 * A + 32 * it + l31];
#pragma unroll
    for (int q = 0; q < 8; ++q) { const int item = 128 * q + 64 * it + lane, j = item >> 4, cl = item & 15;
        G.raw[q] = *(const u32x4*)(T.G + ((C0 + (unsigned)j) * 512u + (unsigned)(gg * 128 + cl * 8))); G.rj[q] = T.ssqg[(C0 + (unsigned)j) * 4u + (unsigned)gg]; }
#pragma unroll
    for (int ct = 0; ct < 4; ++ct)
#pragma unroll
        for (int g4 = 0; g4 < 4; ++g4) G.uu[ct][g4] = *(const u32x2*)(T.U + (prow * 512u + (unsigned)(gg * 128 + 32 * ct + 8 * g4 + 4 * h)));
}
template <int A>
__device__ __forceinline__ void gate_part(MX_LAS unsigned char* lds, const MixTensors& T, size_t R0, int wid, GateRegs<A>& G) {
    MX_LAS float* SS2 = (MX_LAS float*)(lds + SS2_OFF);
    const int lane = hw_lane();
    const int l31 = lane & 31, h = lane >> 5;
    constexpr int NC = 8 * (A + 1), NKS = 4 * (A + 1);
    const int gg = wid >> 1, it = wid & 1;
    const unsigned C0 = (unsigned)R0 - 64u * (unsigned)A;
    MX_LAS bf16* Gr = (MX_LAS bf16*)(lds + gg * GT_BYTES);
    const float bias = G.bias;
#pragma unroll
    for (int q0 = 0; q0 < NC; q0 += 8) {
        u32x4 raw[8]; float rj[8];
#pragma unroll
        for (int q = 0; q < 8; ++q) { const int item = 128 * (q0 + q) + 64 * it + lane, j = item >> 4, cl = item & 15;
            if (q0 == 0) { raw[q] = G.raw[q]; rj[q] = G.rj[q]; }
            else { raw[q] = *(const u32x4*)(T.G + ((C0 + (unsigned)j) * 512u + (unsigned)(gg * 128 + cl * 8))); rj[q] = T.ssqg[(C0 + (unsigned)j) * 4u + (unsigned)gg]; } }
        __builtin_amdgcn_sched_barrier(0);
        const int cl = lane & 15;
        const MX_LAS f32x4* vn4 = (const MX_LAS f32x4*)((const MX_LAS float*)(lds + VN_OFF) + gg * 128 + cl * 8); const f32x4 va = vn4[0], vb = vn4[1];
#pragma unroll
        for (int q = 0; q < 8; ++q) { const int item = 128 * (q0 + q) + 64 * it + lane, j = item >> 4;
            const float r = __builtin_amdgcn_rsqf(rj[q] * (1.0f / 128.0f) + EPS);
            u32x4 w;
            w.x = pk2(bf2f(raw[q].x & 0xffffu) * r * va[0], bf2f(raw[q].x >> 16) * r * va[1]); w.y = pk2(bf2f(raw[q].y & 0xffffu) * r * va[2], bf2f(raw[q].y >> 16) * r * va[3]);
            w.z = pk2(bf2f(raw[q].z & 0xffffu) * r * vb[0], bf2f(raw[q].z >> 16) * r * vb[1]); w.w = pk2(bf2f(raw[q].w & 0xffffu) * r * vb[2], bf2f(raw[q].w >> 16) * r * vb[3]);
            *(MX_LAS u32x4*)(Gr + j * GR_STRIDE + cl * 8) = w; }
    }
    __syncthreads();
    f32x16 acc[4];
    const unsigned gaddr = (unsigned)(unsigned long)Gr + (unsigned)(((8 * h + ((lane >> 2) & 3)) * GR_STRIDE + 16 * ((lane >> 4) & 1) + 4 * (lane & 3)) * 2);
#define TRG(ct, ks, t) tr_read<((16 * (ks) + 4 * (t)) * GR_STRIDE + 32 * (ct)) * 2>(gaddr)
#define GATE_CT(CT) do { \
        s16x4 lo[NKS], hi[NKS]; \
        lo[0] = TRG(CT, 0, 0); hi[0] = TRG(CT, 0, 1); lo[1] = TRG(CT, 1, 0); hi[1] = TRG(CT, 1, 1); lo[2] = TRG(CT, 2, 0); hi[2] = TRG(CT, 2, 1); lo[3] = TRG(CT, 3, 0); hi[3] = TRG(CT, 3, 1); \
        if constexpr (NKS == 8) { lo[4] = TRG(CT, 4, 0); hi[4] = TRG(CT, 4, 1); lo[5] = TRG(CT, 5, 0); hi[5] = TRG(CT, 5, 1); lo[6] = TRG(CT, 6, 0); hi[6] = TRG(CT, 6, 1); lo[7] = TRG(CT, 7, 0); hi[7] = TRG(CT, 7, 1); } \
        TR_WAIT(); \
        _Pragma("unroll") for (int r = 0; r < 16; ++r) acc[CT][r] = 0.f; \
        _Pragma("unroll") for (int ks = 0; ks < NKS; ++ks) acc[CT] = MX_MFMA(__builtin_shufflevector(lo[ks], hi[ks], 0, 1, 2, 3, 4, 5, 6, 7), G.Bw[ks], acc[CT]); } while (0)
    GATE_CT(0); GATE_CT(1); GATE_CT(2); GATE_CT(3);
#undef GATE_CT
#undef TRG
    float gss = 0.f;
#pragma unroll
    for (int ct = 0; ct < 4; ++ct)
#pragma unroll
        for (int g4 = 0; g4 < 4; ++g4) {
            const float u0 = bf2f(G.uu[ct][g4].x & 0xffffu), u1 = bf2f(G.uu[ct][g4].x >> 16), u2 = bf2f(G.uu[ct][g4].y & 0xffffu), u3 = bf2f(G.uu[ct][g4].y >> 16);
            const float g0 = u0 * (acc[ct][4 * g4] + bias), g1 = u1 * (acc[ct][4 * g4 + 1] + bias), g2 = u2 * (acc[ct][4 * g4 + 2] + bias), g3 = u3 * (acc[ct][4 * g4 + 3] + bias);
            acc[ct][4 * g4] = g0; acc[ct][4 * g4 + 1] = g1; acc[ct][4 * g4 + 2] = g2; acc[ct][4 * g4 + 3] = g3; gss += (g0 * g0 + g1 * g1) + (g2 * g2 + g3 * g3); }
    gss += __shfl_xor(gss, 32);
    if (h == 0) SS2[wid * 32 + l31] = gss;
    __syncthreads();
    float tot = 0.f;
#pragma unroll
    for (int g2 = 0; g2 < 4; ++g2) tot += SS2[(2 * g2 + it) * 32 + l31];
    const float rg = __builtin_amdgcn_rsqf(tot * (1.0f / 512.0f) + EPS);
    MX_LAS bf16* GO = (MX_LAS bf16*)(lds + KS_OFF);
#pragma unroll
    for (int ct = 0; ct < 4; ++ct)
#pragma unroll
        for (int g4 = 0; g4 < 4; ++g4) { u32x2 w2; w2.x = pk2(acc[ct][4 * g4] * rg, acc[ct][4 * g4 + 1] * rg); w2.y = pk2(acc[ct][4 * g4 + 2] * rg, acc[ct][4 * g4 + 3] * rg);
            *(MX_LAS u32x2*)(GO + (32 * it + l31) * AO_STRIDE + gg * 128 + 32 * ct + 8 * g4 + 4 * h) = w2; }
    __syncthreads();
#pragma unroll
    for (int r8 = 0; r8 < 8; ++r8) { const int row = wid * 8 + r8;
        const u32x4 v = *(const MX_LAS u32x4*)(GO + row * AO_STRIDE + lane * 8); mrg_store(T.MRG, (((unsigned)R0 + (unsigned)row) * 1024u + (unsigned)(512 + lane * 8)) * 2u, v); }
    __syncthreads();
}

template <int A>
__device__ __forceinline__ void prompt_tail(MX_LAS unsigned char* lds, const MixTensors& T, size_t R0, int wid, const f32x16 (&o0)[2], const f32x16 (&o1)[2], float ss0, float ss1) {
    GateRegs<A> GR; gate_issue<A>(T, R0, wid, GR);
    __builtin_amdgcn_sched_barrier(0);
    const int lane = hw_lane(), l31 = lane & 31, h = lane >> 5; const int hh = wid;
    MX_LAS float* SS = (MX_LAS float*)(lds + SS_OFF);
    if (h == 0) { SS[wid * 64 + l31] = ss0; SS[wid * 64 + 32 + l31] = ss1; }
    __syncthreads();
    { MX_LAS bf16* AO = (MX_LAS bf16*)(lds + KS_OFF);
      float t0 = 0.f, t1 = 0.f;
#pragma unroll
      for (int w = 0; w < 8; ++w) { t0 += SS[w * 64 + l31]; t1 += SS[w * 64 + 32 + l31]; }
      const float ra0 = __builtin_amdgcn_rsqf(t0 * (1.0f / 512.0f) + EPS), ra1 = __builtin_amdgcn_rsqf(t1 * (1.0f / 512.0f) + EPS);
#pragma unroll
      for (int dt = 0; dt < 2; ++dt)
#pragma unroll
          for (int g4 = 0; g4 < 4; ++g4) { u32x2 w0, w1;
              w0.x = pk2(o0[dt][4 * g4] * ra0, o0[dt][4 * g4 + 1] * ra0); w0.y = pk2(o0[dt][4 * g4 + 2] * ra0, o0[dt][4 * g4 + 3] * ra0);
              w1.x = pk2(o1[dt][4 * g4] * ra1, o1[dt][4 * g4 + 1] * ra1); w1.y = pk2(o1[dt][4 * g4 + 2] * ra1, o1[dt][4 * g4 + 3] * ra1);
              *(MX_LAS u32x2*)(AO + l31 * AO_STRIDE + hh * 64 + 32 * dt + 8 * g4 + 4 * h) = w0; *(MX_LAS u32x2*)(AO + (32 + l31) * AO_STRIDE + hh * 64 + 32 * dt + 8 * g4 + 4 * h) = w1; }
      __syncthreads();
#pragma unroll
      for (int r8 = 0; r8 < 8; ++r8) { const int row = wid * 8 + r8;
          const u32x4 v = *(const MX_LAS u32x4*)(AO + row * AO_STRIDE + lane * 8); mrg_store(T.MRG, (((unsigned)R0 + (unsigned)row) * 1024u + (unsigned)(lane * 8)) * 2u, v); }
      __syncthreads(); }
    gate_part<A>(lds, T, R0, wid, GR);
}
__device__ __forceinline__ void prompt_unit(MX_LAS unsigned char* lds, const MixTensors& T, int b, int u64, int wid) {
    const int lane = hw_lane(), l31 = lane & 31, h = lane >> 5;
    const int t0 = u64 * 64; const size_t R0 = (size_t)b * 8192 + t0;
    MX_LAS bf16* Ks = (MX_LAS bf16*)(lds + KS_OFF); MX_LAS bf16* Vt = (MX_LAS bf16*)(lds + VT_OFF);
    MX_LAS float* SS = (MX_LAS float*)(lds + SS_OFF);
    const int hh = wid, kvh = hh >> 2;
    bf16x8 qf[2][4];
    const unsigned rowb = (unsigned)b * 8192u;
    { u32x4 kreg[6], vreg[6];
#pragma unroll
      for (int it = 0; it < 6; ++it) {
          const int idx = it * 512 + wid * 64 + lane, kr = idx >> 4, kc = idx & 15, kp = t0 - 128 + kr;
          const unsigned g = (rowb + (unsigned)(kp < 0 ? 0 : kp)) * 128u + (unsigned)(kc * 8);
          kreg[it] = *(const u32x4*)(T.K + g); vreg[it] = *(const u32x4*)(T.V + g);
          if (kp < 0) { kreg[it] = (u32x4){0u, 0u, 0u, 0u}; vreg[it] = (u32x4){0u, 0u, 0u, 0u}; } }
#pragma unroll
      for (int qt = 0; qt < 2; ++qt) { const bf16* qrow = T.Q + ((unsigned)R0 + (unsigned)(32 * qt + l31)) * 512u + (unsigned)(hh * 64 + 8 * h);
#pragma unroll
          for (int ks = 0; ks < 4; ++ks) qf[qt][ks] = *(const bf16x8*)(qrow + 16 * ks); }
#pragma unroll
      for (int it = 0; it < 6; ++it) { const int idx = it * 512 + wid * 64 + lane, kr = idx >> 4, kc = idx & 15;
          *(MX_LAS u32x4*)(Ks + kr * KS_STRIDE + kc * 8) = kreg[it]; *(MX_LAS u32x4*)(Vt + kr * VR_STRIDE + kc * 8) = vreg[it]; } }
    __syncthreads();
    const float slope2 = __builtin_amdgcn_exp2f(-(float)(hh + 1)) * LOG2E, sink2 = T.sinks[hh] * LOG2E;
    const int kmin = (t0 >= 128) ? 0 : 128 - t0;
    f32x16 o0[2], o1[2]; float ss0, ss1;
    attn_tile<0>(Ks, Vt, qf[0], kvh, lane, l31, h, kmin, slope2, sink2, o0, ss0);
    attn_tile<1>(Ks, Vt, qf[1], kvh, lane, l31, h, kmin, slope2, sink2, o1, ss1);
    if (u64 & 1) prompt_tail<1>(lds, T, R0, wid, o0, o1, ss0, ss1); else prompt_tail<0>(lds, T, R0, wid, o0, o1, ss0, ss1);
}

__device__ __forceinline__ void sample_unit(MX_LAS unsigned char* lds, const MixTensors& T, int s, int wid) {
    const int lane = hw_lane(), tid = wid * 64 + lane, l31 = lane & 31, h = lane >> 5;
    MX_LAS bf16* Ks = (MX_LAS bf16*)(lds + KS_OFF); MX_LAS bf16* Vt = (MX_LAS bf16*)(lds + VT_OFF);
    MX_LAS float* SB = (MX_LAS float*)(lds + SS_OFF);
    const int hh = wid, kvh = hh >> 2; const unsigned row0 = 16384u + 4u * (unsigned)s;
    bf16x8 qf[4];
    { const bf16* qrow = T.Q + (row0 + (unsigned)(l31 < 4 ? l31 : 3)) * 512u + (unsigned)(hh * 64 + 8 * h);
#pragma unroll
      for (int ks = 0; ks < 4; ++ks) qf[ks] = *(const bf16x8*)(qrow + 16 * ks); }
    { f32x4 kq[10];
#pragma unroll
      for (int q = 0; q < 10; ++q) { const int item = tid + 512 * q, row = item >> 5, c4 = item & 31, rr = row < 132 ? row : 131;
          const float* src = ((rr < 128) ? T.cache_k : T.sk_out) + ((unsigned)(s * 128 + (rr < 128 ? rr : rr - 4)) * 128u + (unsigned)(4 * c4));
          kq[q] = *(const f32x4*)src; }
      __builtin_amdgcn_sched_barrier(0);
#pragma unroll
      for (int q = 0; q < 10; ++q) { const int item = tid + 512 * q, row = item >> 5, c4 = item & 31; u32x2 w; if (row >= 132) kq[q] = (f32x4){0.f, 0.f, 0.f, 0.f}; w.x = pk2(kq[q][0], kq[q][1]); w.y = pk2(kq[q][2], kq[q][3]); *(MX_LAS u32x2*)(Ks + row * KS_STRIDE + 4 * c4) = w; } }
    { f32x4 vq[10];
#pragma unroll
      for (int q = 0; q < 10; ++q) { const int item = tid + 512 * q, row = item >> 5, c4 = item & 31, rr = row < 132 ? row : 131;
          const float* src = ((rr < 128) ? T.cache_v : T.sv_out) + ((unsigned)(s * 128 + (rr < 128 ? rr : rr - 4)) * 128u + (unsigned)(4 * c4));
          vq[q] = *(const f32x4*)src; }
      __builtin_amdgcn_sched_barrier(0);
#pragma unroll
      for (int q = 0; q < 10; ++q) { const int item = tid + 512 * q, row = item >> 5, c4 = item & 31; u32x2 w; if (row >= 132) vq[q] = (f32x4){0.f, 0.f, 0.f, 0.f};
          w.x = pk2(vq[q][0], vq[q][1]); w.y = pk2(vq[q][2], vq[q][3]); *(MX_LAS u32x2*)(Vt + row * VR_STRIDE + 4 * c4) = w; } }
    const int c = tid, gg = c >> 7;
    float gn[4], uv[4], wv[10], bv[4]; const float vnc = T.vnorm[c];
#pragma unroll
    for (int j = 0; j < 4; ++j) { gn[j] = bf2f(T.G[(row0 + j) * 512u + (unsigned)c]) * __builtin_amdgcn_rsqf(T.ssqg[(row0 + j) * 4u + (unsigned)gg] * (1.0f / 128.0f) + EPS) * vnc; uv[j] = bf2f(T.U[(row0 + j) * 512u + (unsigned)c]); bv[j] = T.bsp[gg * 128 + j]; }
#pragma unroll
    for (int i = 0, n = 0; i < 4; ++i)
#pragma unroll
        for (int j = 0; j <= i; ++j, ++n) wv[n] = T.wsp[(unsigned)(gg * 128 + i) * 128u + (unsigned)j];
    __syncthreads();
    const float slope2 = __builtin_amdgcn_exp2f(-(float)(hh + 1)) * LOG2E, sink2 = T.sinks[hh] * LOG2E;
    f32x16 o[2]; float ss;
    attn_tile<0>(Ks, Vt, qf, kvh, lane, l31, h, 0, slope2, sink2, o, ss);
    if (lane < 4) SB[wid * 4 + lane] = ss;
    float gate[4];
#pragma unroll
    for (int i = 0, n = 0; i < 4; ++i) { float mixed = bv[i];
#pragma unroll
        for (int j = 0; j <= i; ++j, ++n) mixed += wv[n] * gn[j];
        gate[i] = uv[i] * mixed; const float w = wave_sum(gate[i] * gate[i]); if (lane == 0) SB[64 + wid * 4 + i] = w;
        T.chunk_out[((unsigned)s * 4u + (unsigned)i) * 512u + (unsigned)c] = gn[i]; }
    __syncthreads();
    { float tot = 0.f;
#pragma unroll
      for (int w = 0; w < 8; ++w) tot += SB[w * 4 + (l31 & 3)];
      if (l31 < 4) attn_store(T.MRG + (row0 + (unsigned)l31) * 1024u + (unsigned)(hh * 64 + 4 * h), o, __builtin_amdgcn_rsqf(tot * (1.0f / 512.0f) + EPS)); }
#pragma unroll
    for (int i = 0; i < 4; ++i) { float tg = 0.f;
#pragma unroll
        for (int w = 0; w < 8; ++w) tg += SB[64 + w * 4 + i];
        T.MRG[(row0 + i) * 1024u + 512u + (unsigned)c] = (bf16)f2bf(gate[i] * __builtin_amdgcn_rsqf(tg * (1.0f / 512.0f) + EPS)); }
    __syncthreads();
}
__device__ __forceinline__ void mix_phase(MX_LAS unsigned char* lds, const MixTensors& T, int vcu, int G, int wid, int which = 3) {
    { const int lane0 = hw_lane(); ((MX_LAS float*)(lds + VN_OFF))[wid * 64 + lane0] = T.vnorm[wid * 64 + lane0]; }
    if (which & 1) for (int u = vcu; u < 256; u += G) prompt_unit(lds, T, u >> 7, u & 127, wid);
    if (which & 2) for (int rep = 0; rep < ((which & 4) ? 2 : 1); ++rep) for (int s = vcu; s < 128; s += G) sample_unit(lds, T, s, wid);
}
}

constexpr int NWAVES = 8;
#ifndef MK_N_LAUNCHES
#define MK_N_LAUNCHES 1
#endif
constexpr int N_PHASES = 8;
constexpr int N_LAUNCHES = MK_N_LAUNCHES;
static_assert(N_LAUNCHES == 1 || N_LAUNCHES == N_PHASES, "MK_N_LAUNCHES is 1 or 8");

constexpr int D = 1024, FF = 2816, NPROJ = 1792, MP = 16384, MS = 512, M = MP + MS;
constexpr size_t O_PK = (size_t)M * D, O_PV = O_PK + 2 * 128 * 128, O_SK = O_PV + 2 * 128 * 128, O_SV = O_SK + (size_t)128 * 128 * 128, O_CH = O_SV + (size_t)128 * 128 * 128, O_END = O_CH + (size_t)128 * 4 * 512;
constexpr size_t MiB = 1u << 20;
constexpr size_t WS_CTL = 0, CTL_ZERO_BYTES = 128 * 1024;   static_assert((8192 + 2 * 72 * 64) * 4 <= 128 * 1024, "CTL words inside the memset region");
constexpr size_t WS_SSQ = 1 * MiB;
constexpr size_t WS_WS = 2 * MiB;
constexpr size_t WS_W1GU = 3 * MiB, WS_W1D = 14 * MiB, WS_WIN = 20 * MiB, WS_WOUT = 24 * MiB, WS_W2GU = 26 * MiB, WS_W2D = 37 * MiB;
constexpr size_t WS_XB = 43 * MiB;
constexpr size_t WS_X12 = 76 * MiB;
constexpr size_t WS_H = 142 * MiB;
constexpr size_t WS_Q = WS_H, WS_K = WS_Q + (size_t)M * 512 * 2, WS_V = WS_K + (size_t)M * 128 * 2, WS_U = WS_V + (size_t)M * 128 * 2, WS_G = WS_U + (size_t)M * 512 * 2, WS_MRG = WS_G + (size_t)M * 512 * 2;
constexpr size_t WS_END = WS_H + (size_t)M * FF * 2;
static_assert(WS_MRG + (size_t)M * D * 2 <= WS_END && WS_END <= 256 * MiB, "d_ws map");
static_assert(WS_W1GU + (size_t)2 * FF * D * 2 <= WS_W1D && WS_W1D + (size_t)D * FF * 2 <= WS_WIN && WS_WIN + (size_t)NPROJ * D * 2 <= WS_WOUT && WS_WOUT + (size_t)D * D * 2 <= WS_W2GU && WS_W2GU + (size_t)2 * FF * D * 2 <= WS_W2D && WS_W2D + (size_t)D * FF * 2 <= WS_XB, "weights map");
static_assert(WS_XB + (size_t)M * D * 2 <= WS_X12 && WS_X12 + (size_t)M * D * 4 <= WS_H && WS_SSQ + (size_t)8 * M * 4 <= WS_SSQ + 768 * 1024, "activations map");
constexpr int CW_FIN = 8192;
constexpr int CW_BAR = 4096;
constexpr int RING_OFF = 0, RING_BYTES = 131072;
constexpr int LDS_BYTES = 163840;
constexpr int LDSCTL_OFF = LDS_BYTES - 1024, MISC_OFF = LDSCTL_OFF + 320;
static_assert(MISC_OFF + 128 <= LDS_BYTES && mixp::MIX_LDS_BYTES <= LDSCTL_OFF && RING_BYTES <= LDSCTL_OFF, "LDS map");

#define GAS __attribute__((address_space(1)))
#define LAS __attribute__((address_space(3)))
typedef unsigned short bf16;
typedef unsigned v4u __attribute__((ext_vector_type(4)));
typedef float f32x4 __attribute__((ext_vector_type(4)));
typedef GAS unsigned gu32;
#define RLX_AGENT __ATOMIC_RELAXED, __HIP_MEMORY_SCOPE_AGENT
#define LDS_WAIT() asm volatile("s_waitcnt lgkmcnt(0)" ::: "memory")
#define VM_WAIT() asm volatile("s_waitcnt vmcnt(0)" ::: "memory")
__device__ __forceinline__ unsigned f2bf(float f) { unsigned u = __builtin_bit_cast(unsigned, f); return (u + 0x7fffu + ((u >> 16) & 1u)) >> 16; }
__device__ __forceinline__ unsigned pk2(float lo, float hi) { unsigned r; asm volatile("v_cvt_pk_bf16_f32 %0, %1, %2" : "=v"(r) : "v"(lo), "v"(hi)); return r; }
#define XB_TMO      128
#define XB_XCNT(j)  (256  + 64 * (j))
#define XB_XSUB(j)  (1280 + 64 * (j))
#define XB_XGEN(j)  (2304 + 64 * (j))
#define XB_TOP      3328
#define XB_TOPGEN   3392
#define XCD_BAR_WORDS 3456
#define XB_SPIN_CAP (1u << 18)

__device__ __forceinline__ unsigned xb_ld(unsigned* p)              { return __hip_atomic_load(p, __ATOMIC_RELAXED, __HIP_MEMORY_SCOPE_AGENT); }
__device__ __forceinline__ unsigned xb_add(unsigned* p, unsigned v) { return __hip_atomic_fetch_add(p, v, __ATOMIC_RELAXED, __HIP_MEMORY_SCOPE_AGENT); }
__device__ __forceinline__ unsigned xb_xcc_id() { return (unsigned)__builtin_amdgcn_s_getreg((3 << 11) | 20) & 0xFu; }
#define XB_SPIN(cond, bar) do { unsigned _sp = 0; while (cond) { __builtin_amdgcn_s_sleep(1); \
    if ((++_sp & 255u) == 0u) { if (xb_ld(&(bar)[XB_TMO])) break; if (_sp > XB_SPIN_CAP) { atomicAdd(&(bar)[XB_TMO], 1u); break; } } } } while (0)

struct XcdBarrier {
    unsigned* bar; unsigned x;
    volatile LAS unsigned* st;
};

__device__ __forceinline__ XcdBarrier xcd_barrier_post(unsigned* bar, volatile LAS unsigned* st, bool leader  ) {
    XcdBarrier b; b.bar = bar; b.x = xb_xcc_id(); b.st = st;
    if (leader) (void)xb_add(&bar[XB_XCNT(b.x)], 1u);
    return b;
}
__device__ __forceinline__ void xcd_barrier_complete(unsigned* bar, unsigned x, unsigned& nloc, unsigned& nx) {
    const unsigned G = gridDim.x * gridDim.y * gridDim.z;
    unsigned sum, cnt, mine, sp = 0u;
    for (;;) {
        sum = 0u; cnt = 0u; mine = 0u;
#pragma unroll
        for (unsigned j = 0; j < 16; ++j) { const unsigned c = xb_ld(&bar[XB_XCNT(j)]); sum += c; cnt += (c > 0u) ? 1u : 0u; mine = (j == x) ? c : mine; }
        if (sum == G) break;
        __builtin_amdgcn_s_sleep(1);
        if ((++sp & 255u) == 0u) { if (xb_ld(&bar[XB_TMO])) break; if (sp > XB_SPIN_CAP) { atomicAdd(&bar[XB_TMO], 1u); break; } }
    }
    nloc = mine > 0u ? mine : 1u; nx = cnt > 0u ? cnt : 1u;
}

__device__ __forceinline__ void xcd_barrier(const XcdBarrier& b, bool leader  ) {
    asm volatile("s_waitcnt vmcnt(0)" ::: "memory");
    __syncthreads();
    if (leader) {
        unsigned* bar = b.bar;
        __builtin_amdgcn_s_waitcnt(0);
        unsigned nloc = b.st[0], nx = b.st[1];
        if (nloc == 0u) { xcd_barrier_complete(bar, b.x, nloc, nx); b.st[0] = nloc; b.st[1] = nx; }
        const unsigned old = xb_add(&bar[XB_XSUB(b.x)], 1u);
        const unsigned gen = old / nloc;
        if (old + 1u == (gen + 1u) * nloc) {
            __builtin_amdgcn_fence(__ATOMIC_RELEASE, "agent");
            asm volatile("s_waitcnt vmcnt(0)" ::: "memory");
            const unsigned og = xb_add(&bar[XB_TOP], 1u);
            const unsigned tg = og / nx;
            if (og + 1u == (tg + 1u) * nx) xb_add(&bar[XB_TOPGEN], 1u);
            else XB_SPIN(xb_ld(&bar[XB_TOPGEN]) == tg, bar);
            __builtin_amdgcn_fence(__ATOMIC_ACQUIRE, "agent");
            xb_add(&bar[XB_XGEN(b.x)], 1u);
            asm volatile("s_waitcnt vmcnt(0)" ::: "memory");
        } else {
            XB_SPIN(xb_ld(&bar[XB_XGEN(b.x)]) == gen, bar);
            __builtin_amdgcn_fence(__ATOMIC_ACQUIRE, "agent");
            asm volatile("s_waitcnt vmcnt(0)" ::: "memory");
        }
    }
    __syncthreads();
}

namespace skn {
#define SK_LAS __attribute__((address_space(3)))
typedef unsigned short bf16;
typedef short bf16x8 __attribute__((ext_vector_type(8)));
typedef float f32x4 __attribute__((ext_vector_type(4)));
typedef unsigned u32x2 __attribute__((ext_vector_type(2)));
constexpr int PSTRIDE = 36, PWAVE = 64 * PSTRIDE;
template <bool FINAL>
struct EpiResRow {
    bf16* XB; float* ssq; float scale; float* out; const float* gain; unsigned* cnt;
    __device__ __forceinline__ u32x2 prefetch(int row, int col) const { return *(const u32x2*)(XB + (size_t)row * 1024 + col); }
    __device__ __forceinline__ void operator()(int row, int col, const f32x4& v, int tid, int blk, const u32x2 bw) const {
        const size_t off = (size_t)row * 1024 + col;
        f32x4 o; o[0] = __uint_as_float(bw.x << 16) + v[0] * scale; o[1] = __uint_as_float(bw.x & 0xffff0000u) + v[1] * scale; o[2] = __uint_as_float(bw.y << 16) + v[2] * scale; o[3] = __uint_as_float(bw.y & 0xffff0000u) + v[3] * scale;
        if (!FINAL) { u32x2 w; w.x = pg8::cvt_pk_bf16(o[0], o[1]); w.y = pg8::cvt_pk_bf16(o[2], o[3]); *(u32x2*)(XB + off) = w; }
        float s = (o[0] * o[0] + o[1] * o[1]) + (o[2] * o[2] + o[3] * o[3]);
        s += __shfl_xor(s, 1); s += __shfl_xor(s, 2); s += __shfl_xor(s, 4);
        if ((tid & 7) == 0) atomicAdd(ssq + row, s);
        if (FINAL) {
            asm volatile("s_waitcnt vmcnt(0)" ::: "memory"); __syncthreads();
            unsigned* c = cnt + 64 * blk;
            if (tid == 0) __hip_atomic_fetch_add(c, 1u, __ATOMIC_RELAXED, __HIP_MEMORY_SCOPE_AGENT);
            if (tid < 64) for (unsigned polls = 0; (unsigned)__builtin_amdgcn_readfirstlane(__hip_atomic_load(c, __ATOMIC_RELAXED, __HIP_MEMORY_SCOPE_AGENT)) < 32u && polls < (1u << 20); ++polls) __builtin_amdgcn_s_sleep(2);
            __syncthreads();
            const float r = __builtin_amdgcn_rsqf(__hip_atomic_load(ssq + row, __ATOMIC_RELAXED, __HIP_MEMORY_SCOPE_AGENT) * (1.0f / 1024.0f) + 1e-6f);
            const f32x4 g = *(const f32x4*)(gain + col);
            *(f32x4*)(out + off) = o * r * g;
        }
    }
};
constexpr int STG_STRIDE = 72, STG_WAVE = 6 * 16 * STG_STRIDE;
template <int K, class EpiT>
__device__ __forceinline__ void skinny_phase(SK_LAS unsigned char* lds, const bf16* A, const bf16* Bt, int row_base, int vcu, int G, const EpiT& E, int wid) {
    const int lane = hw_lane(), tid = wid * 64 + lane;
    constexpr int NPT = K / 64, NPW = (NPT + 7) / 8, PBASE = NPT / 8, PREM = NPT % 8;
    static_assert(NPW <= 6 && 8 * STG_WAVE * 2 <= 131072, "skinny staging");
    const int npw = PBASE + (wid < PREM ? 1 : 0), pbeg = wid * PBASE + (wid < PREM ? wid : PREM);
    const int fr = lane & 15, fq = lane >> 4, r8 = lane >> 3, c8 = lane & 7;
    SK_LAS float* P = (SK_LAS float*)lds;
    SK_LAS bf16* SW = (SK_LAS bf16*)lds + wid * STG_WAVE;
    for (int tile = vcu; tile < 256; tile += G) {
        const int rt = tile & 7, ct = 4 * (tile >> 5) + ((tile >> 3) & 3);
        const int r0 = row_base + 64 * rt, c0 = 32 * ct;
        const u32x2 resid = E.prefetch(r0 + (tid >> 3), c0 + (tid & 7) * 4);
        f32x4 acc[4][2];
#pragma unroll
        for (int m = 0; m < 4; ++m)
#pragma unroll
            for (int n = 0; n < 2; ++n) acc[m][n] = (f32x4){0.f, 0.f, 0.f, 0.f};
        const bf16* apc = A + (size_t)(r0 + r8) * K + pbeg * 64 + 8 * c8; const bf16* bpc = Bt + (size_t)(c0 + r8) * K + pbeg * 64 + 8 * c8;
        bf16x8 ra[3][4][2], rb[3][2][2];
#define SK_LOAD(buf, q) do { const int qc_ = ((q) < npw ? (q) : npw - 1) * 64;     \
            _Pragma("unroll") for (int t = 0; t < 4; ++t) _Pragma("unroll") for (int i = 0; i < 2; ++i) ra[buf][t][i] = *(const bf16x8*)(apc + (size_t)(16 * t + 8 * i) * K + qc_); \
            _Pragma("unroll") for (int t = 0; t < 2; ++t) _Pragma("unroll") for (int i = 0; i < 2; ++i) rb[buf][t][i] = *(const bf16x8*)(bpc + (size_t)(16 * t + 8 * i) * K + qc_); } while (0)
#define SK_PAIR(buf, q) do { if ((q) < npw) {                         \
            _Pragma("unroll") for (int t = 0; t < 4; ++t) _Pragma("unroll") for (int i = 0; i < 2; ++i) *(SK_LAS bf16x8*)(SW + (t * 16 + 8 * i + r8) * STG_STRIDE + 8 * c8) = ra[buf][t][i]; \
            _Pragma("unroll") for (int t = 0; t < 2; ++t) _Pragma("unroll") for (int i = 0; i < 2; ++i) *(SK_LAS bf16x8*)(SW + ((4 + t) * 16 + 8 * i + r8) * STG_STRIDE + 8 * c8) = rb[buf][t][i]; \
            _Pragma("unroll") for (int s2 = 0; s2 < 2; ++s2) { bf16x8 fa[4], fb[2]; \
                _Pragma("unroll") for (int m = 0; m < 4; ++m) fa[m] = *(const SK_LAS bf16x8*)(SW + (m * 16 + fr) * STG_STRIDE + 8 * (4 * s2 + fq)); \
                _Pragma("unroll") for (int n = 0; n < 2; ++n) fb[n] = *(const SK_LAS bf16x8*)(SW + ((4 + n) * 16 + fr) * STG_STRIDE + 8 * (4 * s2 + fq)); \
                _Pragma("unroll") for (int m = 0; m < 4; ++m) _Pragma("unroll") for (int n = 0; n < 2; ++n) \
                    acc[m][n] = __builtin_amdgcn_mfma_f32_16x16x32_bf16(fb[n], fa[m], acc[m][n], 0, 0, 0); } } } while (0)
        SK_LOAD(0, 0); if (NPW > 1) SK_LOAD(1, 1); if (NPW > 2) SK_LOAD(2, 2);
        __builtin_amdgcn_sched_barrier(0);
#pragma unroll
        for (int q = 0; q < NPW; ++q) {
            if (q % 3 == 0) { SK_PAIR(0, q); __builtin_amdgcn_sched_barrier(0); if (q + 3 < NPW) SK_LOAD(0, q + 3); }
            else if (q % 3 == 1) { SK_PAIR(1, q); __builtin_amdgcn_sched_barrier(0); if (q + 3 < NPW) SK_LOAD(1, q + 3); }
            else { SK_PAIR(2, q); __builtin_amdgcn_sched_barrier(0); if (q + 3 < NPW) SK_LOAD(2, q + 3); }
            __builtin_amdgcn_sched_barrier(0);
        }
#undef SK_LOAD
#undef SK_PAIR
        __syncthreads();
#pragma unroll
        for (int m = 0; m < 4; ++m)
#pragma unroll
            for (int n = 0; n < 2; ++n) *(SK_LAS f32x4*)(P + wid * PWAVE + (16 * m + fr) * PSTRIDE + 16 * n + 4 * fq) = acc[m][n];
        __syncthreads();
        const int row = tid >> 3, c4 = (tid & 7) * 4;
        f32x4 s = (f32x4){0.f, 0.f, 0.f, 0.f};
#pragma unroll
        for (int w = 0; w < 8; ++w) s += *(const SK_LAS f32x4*)(P + w * PWAVE + row * PSTRIDE + c4);
        E(r0 + row, c0 + c4, s, tid, rt, resid);
        __syncthreads();
    }
}
}

struct Frame {
    LAS unsigned char* lds;
    volatile LAS unsigned* MISC;
    gu32* ctl;
    int wave, vcu, G;
};
__device__ __forceinline__ float wave_sum(float v) {
#pragma unroll
    for (int o = 1; o < 64; o <<= 1) v += __shfl_xor(v, o);
    return v;
}
struct TrItem { const float* W; const float* gain; bf16* WT; int K, N, gu, item; };
__device__ __forceinline__ void tr_load(const TrItem& d, int lane, f32x4 (&v)[8], float (&gv)[8]) {
    const int nblk = d.N / 32, kb = d.item / nblk, nb = d.item - kb * nblk, k0 = 64 * kb, n0 = 32 * nb;
#pragma unroll
    for (int i = 0; i < 8; ++i) { const int kk = i * 8 + (lane >> 3); v[i] = __builtin_nontemporal_load((const GAS f32x4*)(d.W + (size_t)(k0 + kk) * d.N + n0 + 4 * (lane & 7))); }
    if (d.gain) {
#pragma unroll
        for (int i = 0; i < 8; ++i) gv[i] = d.gain[k0 + i * 8 + (lane >> 3)];
    } else {
#pragma unroll
        for (int i = 0; i < 8; ++i) gv[i] = 1.0f; }
}
__device__ __forceinline__ void tr_finish(const TrItem& d, int lane, LAS float* scr, const f32x4 (&v)[8], const float (&gv)[8]) {
    const int nblk = d.N / 32, kb = d.item / nblk, nb = d.item - kb * nblk, k0 = 64 * kb, n0 = 32 * nb;
    const int drow0 = (d.gu == 0) ? n0 : 256 * (n0 >> 7) + (n0 & 127) + (d.gu == 2 ? 128 : 0);
#pragma unroll
    for (int i = 0; i < 8; ++i) { const int kk = i * 8 + (lane >> 3); LAS float* t = scr + kk * 33 + 4 * (lane & 7); t[0] = v[i].x * gv[i]; t[1] = v[i].y * gv[i]; t[2] = v[i].z * gv[i]; t[3] = v[i].w * gv[i]; }
    LDS_WAIT(); asm volatile("" ::: "memory");
    const int c = lane & 7;
#pragma unroll
    for (int j = 0; j < 4; ++j) { const int n = (lane >> 3) + 8 * j; const LAS float* t = scr + (8 * c) * 33 + n;
        v4u o; o.x = pk2(t[0 * 33], t[1 * 33]); o.y = pk2(t[2 * 33], t[3 * 33]); o.z = pk2(t[4 * 33], t[5 * 33]); o.w = pk2(t[6 * 33], t[7 * 33]);
        __builtin_amdgcn_raw_buffer_store_b128(o, __builtin_amdgcn_make_buffer_rsrc(d.WT, 0, 0x7fffffff, 0x00020000), (unsigned)(((size_t)(drow0 + n) * d.K + k0 + 8 * c) * 2), 0, 16); }
    LDS_WAIT(); asm volatile("" ::: "memory");
}
struct Args { const float* in[22]; float* out; unsigned char* ws; int ph_lo, ph_hi, li, pad; };
typedef const __attribute__((address_space(4))) Args* KArgs;
__device__ __forceinline__ KArgs kargs() { KArgs p = (KArgs)__builtin_amdgcn_kernarg_segment_ptr(); asm volatile("" : "+s"(p)); return p; }
enum { I_XP = 0, I_XS, I_CK, I_CV, I_N1, I_W1G, I_W1U, I_W1D, I_NM, I_WIN, I_SINK, I_VN, I_WSP, I_BSP, I_AON, I_GON, I_WOUT, I_N2, I_W2G, I_W2U, I_W2D, I_FN };

#ifndef MK_COPY_AUX
#define MK_COPY_AUX 16
#endif
__device__ __forceinline__ void cache_copy(const KArgs A, int which, int lane, int gw, int NGW) {
    const f32x4* src = (const f32x4*)A->in[which ? I_CV : I_CK]; f32x4* dst = (f32x4*)(A->out + (which ? O_SV : O_SK));
    constexpr int NCP = 128 * 3968;
    for (int idx0 = gw * 64 + lane; idx0 < NCP; idx0 += 4 * NGW * 64) { f32x4 a[4];
#pragma unroll
        for (int t = 0; t < 4; ++t) { int idx = idx0 + t * NGW * 64; idx = idx < NCP ? idx : NCP - 1; const int s = idx / 3968, r = idx - s * 3968; a[t] = src[(size_t)s * 4096 + 128 + r]; }
#pragma unroll
        for (int t = 0; t < 4; ++t) { const int idx = idx0 + t * NGW * 64; if (idx < NCP) { const int s = idx / 3968, r = idx - s * 3968; __builtin_amdgcn_raw_buffer_store_b128(__builtin_bit_cast(v4u, a[t]), __builtin_amdgcn_make_buffer_rsrc((void*)dst, 0, 0x7fffffff, 0x00020000), (unsigned)(((unsigned)s * 4096u + (unsigned)r) * 16u), 0, MK_COPY_AUX); } } }
}
constexpr int I_GU = (D / 64) * (FF / 32), I_DN = (FF / 64) * (D / 32), I_IN = (D / 64) * (NPROJ / 32), I_OUT = (D / 64) * (D / 32);
constexpr int W_P1 = 2 * I_GU, W_P3 = W_P1 + I_DN + I_IN + I_OUT, W_P6 = W_P3 + 2 * I_GU, W_END = W_P6 + I_DN;
__device__ __forceinline__ TrItem tr_item(const KArgs A, int it) {
    unsigned char* ws = A->ws; int r = it; TrItem d;
    if (r < I_GU) { d = TrItem{A->in[I_W1G], A->in[I_N1], (bf16*)(ws + WS_W1GU), D, FF, 1, r}; return d; } r -= I_GU;
    if (r < I_GU) { d = TrItem{A->in[I_W1U], A->in[I_N1], (bf16*)(ws + WS_W1GU), D, FF, 2, r}; return d; } r -= I_GU;
    if (r < I_DN) { d = TrItem{A->in[I_W1D], nullptr, (bf16*)(ws + WS_W1D), FF, D, 0, r}; return d; } r -= I_DN;
    if (r < I_IN) { d = TrItem{A->in[I_WIN], A->in[I_NM], (bf16*)(ws + WS_WIN), D, NPROJ, 0, r}; return d; } r -= I_IN;
    if (r < I_OUT) { const int k0 = 64 * (r / (D / 32)); d = TrItem{A->in[I_WOUT], (k0 < 512) ? A->in[I_AON] : A->in[I_GON] - 512, (bf16*)(ws + WS_WOUT), D, D, 0, r}; return d; } r -= I_OUT;
    if (r < I_GU) { d = TrItem{A->in[I_W2G], A->in[I_N2], (bf16*)(ws + WS_W2GU), D, FF, 1, r}; return d; } r -= I_GU;
    if (r < I_GU) { d = TrItem{A->in[I_W2U], A->in[I_N2], (bf16*)(ws + WS_W2GU), D, FF, 2, r}; return d; } r -= I_GU;
    d = TrItem{A->in[I_W2D], nullptr, (bf16*)(ws + WS_W2D), FF, D, 0, r}; return d;
}
__device__ __forceinline__ void weight_items(const KArgs A, LAS float* scr, int lane, int lo, int hi, int gw, int NGW) {
    int it = lo + gw; if (it >= hi) return;
    f32x4 va[8], vb[8]; float ga[8], gb[8];
    TrItem da = tr_item(A, it), db = da; tr_load(da, lane, va, ga);
    for (;;) {
        const bool more_b = it + NGW < hi; if (more_b) { db = tr_item(A, it + NGW); tr_load(db, lane, vb, gb); }
        tr_finish(da, lane, scr, va, ga);
        if (!more_b) break; it += NGW;
        const bool more_a = it + NGW < hi; if (more_a) { da = tr_item(A, it + NGW); tr_load(da, lane, va, ga); }
        tr_finish(db, lane, scr, vb, gb);
        if (!more_a) break; it += NGW;
    }
}
__device__ __forceinline__ void tril_items(const KArgs A, int lane, int gw, int NGW) {
    bf16* WSb = (bf16*)(A->ws + WS_WS); const float* wsp = A->in[I_WSP];
    for (int idx = gw * 64 + lane; idx < 4 * 128 * 128; idx += NGW * 64) { const int i = (idx >> 7) & 127, j = idx & 127; WSb[idx] = (bf16)((j <= i) ? f2bf(wsp[idx]) : 0u); }
}
__device__ __forceinline__ void deferred_weights(Frame& F, int nunits, int lo, int hi, bool with_tril, int copy_which = -1) {
    const int first_idle = nunits % F.G, c = (int)blockIdx.x;
    if (first_idle == 0 || c < first_idle) return;
    const KArgs A = kargs(); const int lane = hw_lane();
    LAS float* scr = (LAS float*)(F.lds + RING_OFF + F.wave * 16384);
    const int gw = (c - first_idle) * NWAVES + F.wave, NGW = (F.G - first_idle) * NWAVES;
    weight_items(A, scr, lane, lo, hi, gw, NGW);
    if (with_tril) tril_items(A, lane, gw, NGW);
    if (copy_which >= 0) cache_copy(A, copy_which, lane, gw, NGW);
}
__device__ __forceinline__ void p0_prologue(Frame& F) {
    const KArgs A = kargs();
    LAS float* scr = (LAS float*)(F.lds + RING_OFF + F.wave * 16384);
    const int lane = hw_lane();
    const int gw = F.vcu * NWAVES + F.wave, NGW = F.G * NWAVES;
    unsigned char* ws = A->ws;
#ifdef PROBE_PRETOUCH
    { const GAS f32x4* xp = (const GAS f32x4*)A->in[I_XP]; f32x4 accv = (f32x4){0.f, 0.f, 0.f, 0.f};
      for (int i0 = gw * 64 + lane; i0 < MP * D / 4; i0 += 8 * NGW * 64) { f32x4 t[8];
#pragma unroll
          for (int u = 0; u < 8; ++u) { int i = i0 + u * NGW * 64; i = i < MP * D / 4 ? i : MP * D / 4 - 1; t[u] = xp[i]; }
#pragma unroll
          for (int u = 0; u < 8; ++u) accv += t[u]; }
      asm volatile("" :: "v"(accv.x), "v"(accv.y), "v"(accv.z), "v"(accv.w)); }
#endif
    weight_items(A, scr, lane, 0, (N_LAUNCHES == 1 && F.G == 256) ? W_P1 : W_END, gw, NGW);
    if (!(N_LAUNCHES == 1 && F.G == 256)) tril_items(A, lane, gw, NGW);
    { bf16* XB = (bf16*)(ws + WS_XB); float* ssq = (float*)(ws + WS_SSQ);
      for (int m0 = gw; m0 < M; m0 += 2 * NGW) {
          f32x4 v[2][4]; float s[2];
#pragma unroll
          for (int t = 0; t < 2; ++t) { const int m = (m0 + t * NGW < M) ? m0 + t * NGW : m0;
              const float* xrow = (m < MP) ? A->in[I_XP] + (size_t)m * D : A->in[I_XS] + (size_t)(m - MP) * D; const GAS f32x4* xr = (const GAS f32x4*)xrow + lane;
#pragma unroll
              for (int j = 0; j < 4; ++j) v[t][j] = __builtin_nontemporal_load(xr + 64 * j); }
#pragma unroll
          for (int t = 0; t < 2; ++t) { const int m = m0 + t * NGW; s[t] = 0.f;
#pragma unroll
              for (int j = 0; j < 4; ++j) s[t] += (v[t][j].x * v[t][j].x + v[t][j].y * v[t][j].y) + (v[t][j].z * v[t][j].z + v[t][j].w * v[t][j].w);
              s[t] = wave_sum(s[t]);
              if (m < M) { GAS unsigned long long* o8 = (GAS unsigned long long*)(XB + (size_t)m * D) + lane;
#pragma unroll
                  for (int j = 0; j < 4; ++j) __hip_atomic_store((unsigned long long*)(o8 + 64 * j), (unsigned long long)pk2(v[t][j].x, v[t][j].y) | ((unsigned long long)pk2(v[t][j].z, v[t][j].w) << 32), __ATOMIC_RELAXED, __HIP_MEMORY_SCOPE_AGENT);
                  if (lane == 0) ssq[m] = s[t]; } } }
      for (int idx = gw * 64 + lane; idx < 7 * M; idx += NGW * 64) ssq[M + idx] = 0.f; }
    if (!(N_LAUNCHES == 1 && F.G == 256)) { cache_copy(A, 0, lane, gw, NGW); cache_copy(A, 1, lane, gw, NGW); }
}
#ifndef PROBE_DUP
#define PROBE_DUP -1
#endif
#define WSP(T, off) ((T*)(ws + (off)))
__device__ __forceinline__ void ph_ffn_up(Frame& F, int which, int rep) {
    const KArgs A = kargs(); unsigned char* ws = A->ws; float* ssq = WSP(float, WS_SSQ);
    pg8::Gemm g{WSP(const bf16, WS_XB), WSP(const bf16, which ? WS_W2GU : WS_W1GU), M, 2 * FF, D}; pg8::StaticOrder S; S.init(M, 2 * FF, F.G, (int)blockIdx.x);
    pg8::EpiSwiGLU E{WSP(bf16, WS_H), FF, ssq + (which ? 2 * M : 0)};
    pg8::gemm_phase<pg8::EpiSwiGLU, pg8::StaticOrder, true, true>(F.lds + RING_OFF, g, S, E, F.wave);
    if (N_LAUNCHES == 1 && F.G == 256 && rep == 0) { if (which == 0) deferred_weights(F, (M / 256) * (2 * FF / 256), W_P1, W_P3, true); else deferred_weights(F, (M / 256) * (2 * FF / 256), W_P6, W_END, false, 1); }
}
__device__ __forceinline__ void ph_ffn_down(Frame& F, int which, int rep) {
    const KArgs A = kargs(); unsigned char* ws = A->ws; float* ssq = WSP(float, WS_SSQ);
    float* sq = rep ? WSP(float, WS_SSQ + 768 * 1024) : ssq + (which ? 3 * M : M);
    pg8::Gemm g{WSP(const bf16, WS_H), WSP(const bf16, which ? WS_W2D : WS_W1D), MP, D, FF}; pg8::StaticOrder S; S.init(MP, D, F.G, (int)blockIdx.x);
    bf16* xb = rep ? WSP(bf16, WS_X12) : WSP(bf16, WS_XB);
    if (which == 0) { pg8::EpiRes E{xb, sq, 0.5f}; pg8::gemm_phase<pg8::EpiRes, pg8::StaticOrder, true, true>(F.lds + RING_OFF, g, S, E, F.wave);
        skn::EpiResRow<false> R{xb, sq, 0.5f, nullptr, nullptr, nullptr}; skn::skinny_phase<FF>(F.lds + RING_OFF, g.A, g.Bt, MP, F.vcu, F.G, R, F.wave);
#ifdef PROBE_SKINNY2
        { skn::EpiResRow<false> R2{WSP(bf16, WS_X12), WSP(float, WS_SSQ + 768 * 1024), 0.5f, nullptr, nullptr, nullptr}; skn::skinny_phase<FF>(F.lds + RING_OFF, g.A, g.Bt, MP, F.vcu, F.G, R2, F.wave); }
#endif
        }
    else { unsigned* cnt = (unsigned*)(ws + WS_CTL) + CW_FIN + (rep ? 72 * 64 : 0); float* outp = rep ? WSP(float, WS_X12) : A->out;
        pg8::EpiFinal E{WSP(const bf16, WS_XB), sq, 0.5f, outp, A->in[I_FN], cnt}; pg8::gemm_phase<pg8::EpiFinal, pg8::StaticOrder, true, true>(F.lds + RING_OFF, g, S, E, F.wave);
        skn::EpiResRow<true> R{WSP(bf16, WS_XB), sq, 0.5f, outp, A->in[I_FN], cnt + 64 * 64}; skn::skinny_phase<FF>(F.lds + RING_OFF, g.A, g.Bt, MP, F.vcu, F.G, R, F.wave); }
}
__device__ __forceinline__ void ph_proj(Frame& F, int rep = 0) {
    const KArgs A = kargs(); unsigned char* ws = A->ws; float* out = A->out;
    pg8::Gemm g{WSP(const bf16, WS_XB), WSP(const bf16, WS_WIN), M, NPROJ, D}; pg8::StaticOrder S; S.init(M, NPROJ, F.G, (int)blockIdx.x);
    pg8::EpiProj E{WSP(bf16, WS_Q), WSP(bf16, WS_K), WSP(bf16, WS_V), WSP(bf16, WS_U), WSP(bf16, WS_G), WSP(float, WS_SSQ) + M, out + O_PK, out + O_PV, out + O_SK, out + O_SV, rep ? WSP(float, WS_MRG) : WSP(float, WS_SSQ) + 4 * M};
    pg8::gemm_phase<pg8::EpiProj, pg8::StaticOrder, true, true>(F.lds + RING_OFF, g, S, E, F.wave);
    if (N_LAUNCHES == 1 && F.G == 256 && rep == 0) deferred_weights(F, (M / 256) * (NPROJ / 256), W_P3, W_P6, false);
}
__device__ __forceinline__ void ph_mix(Frame& F, int which = 3) {
    const KArgs A = kargs(); unsigned char* ws = A->ws; float* out = A->out;
    mixp::MixTensors T{WSP(const bf16, WS_Q), WSP(const bf16, WS_K), WSP(const bf16, WS_V), WSP(const bf16, WS_U), WSP(const bf16, WS_G), WSP(bf16, WS_MRG), WSP(const bf16, WS_WS),
                       A->in[I_SINK], A->in[I_VN], A->in[I_BSP], A->in[I_WSP], A->in[I_CK], A->in[I_CV], out + O_SK, out + O_SV, out + O_CH, WSP(float, WS_SSQ) + 4 * M};
    mixp::mix_phase(F.lds + RING_OFF, T, F.vcu, F.G, F.wave, which);
    if (N_LAUNCHES == 1 && F.G == 256 && which == 3 && F.vcu >= 128) cache_copy(A, 0, hw_lane(), (F.vcu - 128) * NWAVES + F.wave, 128 * NWAVES);
}
__device__ __forceinline__ void ph_out(Frame& F, int rep = 0) {
    const KArgs A = kargs(); unsigned char* ws = A->ws;
    pg8::Gemm g{WSP(const bf16, WS_MRG), WSP(const bf16, WS_WOUT), MP, D, D}; pg8::StaticOrder S; S.init(MP, D, F.G, (int)blockIdx.x);
    float* sq = rep ? WSP(float, WS_SSQ + 768 * 1024) : WSP(float, WS_SSQ) + 2 * M; bf16* xb = rep ? WSP(bf16, WS_X12) : WSP(bf16, WS_XB);
    pg8::EpiRes E{xb, sq, 1.0f};
    pg8::gemm_phase<pg8::EpiRes, pg8::StaticOrder, true, true>(F.lds + RING_OFF, g, S, E, F.wave);
    skn::EpiResRow<false> R{xb, sq, 1.0f, nullptr, nullptr, nullptr}; skn::skinny_phase<D>(F.lds + RING_OFF, g.A, g.Bt, MP, F.vcu, F.G, R, F.wave);
}
__global__ void __launch_bounds__(NWAVES * 64, 2) mk_fwd(Args args) {
    extern __shared__ __attribute__((aligned(16))) unsigned char lds[];
    Frame F;
    F.lds = (LAS unsigned char*)lds;
    F.MISC = (volatile LAS unsigned*)(F.lds + MISC_OFF);
    const int tid0 = threadIdx.x; F.wave = __builtin_amdgcn_readfirstlane(tid0 >> 6);
    F.G = gridDim.x; { const int bx = blockIdx.x; F.vcu = (F.G % 8 == 0) ? (bx % 8) * (F.G / 8) + bx / 8 : bx; }
    F.ctl = (gu32*)(kargs()->ws + WS_CTL);
    for (int u = tid0; u < (LDS_BYTES - LDSCTL_OFF) / 4; u += NWAVES * 64) ((LAS unsigned*)(F.lds + LDSCTL_OFF))[u] = 0u;
    __syncthreads();
    XcdBarrier bar; bar.bar = (unsigned*)(F.ctl + CW_BAR); bar.x = 0; bar.st = nullptr;
    if (N_LAUNCHES == 1) bar = xcd_barrier_post((unsigned*)(F.ctl + CW_BAR), F.MISC + 8, tid0 == 0);
#define GRID_BAR() do { if (N_LAUNCHES == 1) xcd_barrier(bar, F.wave == 0 && hw_lane() == 0); } while (0)
    const int lo = kargs()->ph_lo, hi = kargs()->ph_hi;
#define IN(k) (lo <= (k) && (k) < hi)
#define BOTH(k) (IN(k) && IN((k) + 1))
#define PHASE(k, call) do { if (IN(k)) { call; if (BOTH(k)) GRID_BAR(); } } while (0)
#define PHASE_DUP(k, call) do { if (PROBE_DUP == (k) && IN((k) > 9 ? (k) / 10 : (k))) { call; GRID_BAR(); } } while (0)
    PHASE(0, p0_prologue(F));                 PHASE_DUP(0, p0_prologue(F));
    PHASE(1, ph_ffn_up(F, 0, 0));             PHASE_DUP(1, ph_ffn_up(F, 0, 1));
    if (PROBE_DUP == 90) { GRID_BAR(); GRID_BAR(); GRID_BAR(); GRID_BAR(); }
    PHASE(2, ph_ffn_down(F, 0, 0));           PHASE_DUP(2, ph_ffn_down(F, 0, 1));
    PHASE(3, ph_proj(F));                     PHASE_DUP(3, ph_proj(F, 1));
    PHASE(4, ph_mix(F, PROBE_DUP == 43 ? 7 : 3));                      PHASE_DUP(4, ph_mix(F)); PHASE_DUP(41, ph_mix(F, 1)); PHASE_DUP(42, ph_mix(F, 2));
    PHASE(5, ph_out(F));                      PHASE_DUP(5, ph_out(F, 1));
    PHASE(6, ph_ffn_up(F, 1, 0));
    if (PROBE_DUP == 7 && IN(7)) { ph_ffn_down(F, 1, 1); GRID_BAR(); }
    if (IN(7)) ph_ffn_down(F, 1, 0);
#undef IN
#undef BOTH
}

extern "C" void kernel_launch(void* const* d_in, const int* in_sizes, int n_in, void* d_out, int out_size, void* d_ws, size_t ws_size, hipStream_t stream) {
    static int grid = 0;
    if (grid == 0) {
        if (n_in != 22 || in_sizes[0] != MP * D || (size_t)out_size != O_END || ws_size < WS_END) { fprintf(stderr, "kernel_launch: unexpected shapes (n_in %d, in0 %d, out %d, ws %zu); nothing launched\n", n_in, n_in > 0 ? in_sizes[0] : -1, out_size, ws_size); grid = -1; return; }
        int dev = 0, cus = 0, per_cu = 0;
        if (hipGetDevice(&dev) != hipSuccess || hipDeviceGetAttribute(&cus, hipDeviceAttributeMultiprocessorCount, dev) != hipSuccess) { grid = -1; return; }
        if (hipFuncSetAttribute((const void*)mk_fwd, hipFuncAttributeMaxDynamicSharedMemorySize, LDS_BYTES) != hipSuccess) { fprintf(stderr, "kernel_launch: hipFuncSetAttribute failed\n"); grid = -1; return; }
        if (hipOccupancyMaxActiveBlocksPerMultiprocessor(&per_cu, (const void*)mk_fwd, NWAVES * 64, LDS_BYTES) != hipSuccess || per_cu < 1) { fprintf(stderr, "kernel_launch: occupancy query failed (%d)\n", per_cu); (void)hipGetLastError(); per_cu = 1; }
        grid = cus;
    }
    if (grid < 0) return;
    if (hipMemsetAsync((char*)d_ws + WS_CTL, 0, CTL_ZERO_BYTES, stream) != hipSuccess) { fprintf(stderr, "kernel_launch: memset failed\n"); return; }
    Args a{};
    for (int i = 0; i < 22; ++i) a.in[i] = (const float*)d_in[i];
    a.out = (float*)d_out; a.ws = (unsigned char*)d_ws;
    if (N_LAUNCHES == 1) {
        a.ph_lo = 0; a.ph_hi = N_PHASES; a.li = 0;
        void* kargs[] = {&a};
#ifdef MK_PLAIN_LAUNCH
        (void)kargs; hipLaunchKernelGGL(mk_fwd, dim3(grid), dim3(NWAVES * 64), LDS_BYTES, stream, a);
#else
        hipError_t e = hipLaunchCooperativeKernel((const void*)mk_fwd, dim3(grid), dim3(NWAVES * 64), kargs, LDS_BYTES, stream);
        if (e != hipSuccess) fprintf(stderr, "kernel_launch: cooperative launch failed: %s (grid %d)\n", hipGetErrorString(e), grid);
#endif
    } else {
        for (int li = 0; li < N_PHASES; ++li) { a.ph_lo = li; a.ph_hi = li + 1; a.li = li;
            hipLaunchKernelGGL(mk_fwd, dim3(grid), dim3(NWAVES * 64), LDS_BYTES, stream, a); }
    }
}
```
